# Optimizing an MI355X kernel written in HIP

```python
import math
import jax, jax.numpy as jnp
from jax import lax
import numpy as np

D_MODEL = 1024
BATCH = 1
SEQ = 16384
DEPTH = 2
DEC_BATCH = 2
DEC_SEQ = 16384
PAST_LEN = 128

HEAD_DIM = 64
H_A = 8
D_A = H_A * HEAD_DIM
H_B = 8
H_KV = 2
GROUP = H_B // H_KV
D_B = H_B * HEAD_DIM
D_KV = H_KV * HEAD_DIM
D_MIX = D_A + D_B
W_IN_COLS = 3 * D_A + D_B + 2 * D_KV
GRID_W = 64
KH_MAX = 8
KW = 16
WINDOW = 128
BLOCK = 128
D_FF = 2816
CONV_W = 3
EPS = 1e-6

kernel_name = "hymba_natten_swa_convffn_encoder"


def rmsnorm(x, g):
    xf = x.astype(jnp.float32)
    inv = lax.rsqrt(jnp.mean(xf * xf, axis=-1, keepdims=True) + EPS)
    return (xf * inv).astype(x.dtype) * g


def neighbourhood_attention(q, k, v, rpb):
    B, T = q.shape[0], q.shape[1]
    rows = T // GRID_W
    kh = min(KH_MAX, rows)
    scale = 1.0 / math.sqrt(HEAD_DIM)
    q = q.reshape(B, rows, GRID_W, H_A, HEAD_DIM)
    k = k.reshape(B, rows, GRID_W, H_A, HEAD_DIM)
    v = v.reshape(B, rows, GRID_W, H_A, HEAD_DIM)
    cols = np.arange(GRID_W)
    col_start = np.clip(cols - KW // 2, 0, GRID_W - KW)
    col_idx = col_start[:, None] + np.arange(KW)
    dc = jnp.asarray(col_idx - cols[:, None] + (KW - 1))

    def row_step(r):
        rs = jnp.clip(r - kh // 2, 0, rows - kh)
        q_r = lax.dynamic_index_in_dim(q, r, axis=1, keepdims=False)
        k_w = lax.dynamic_slice_in_dim(k, rs, kh, axis=1)[:, :, col_idx]
        v_w = lax.dynamic_slice_in_dim(v, rs, kh, axis=1)[:, :, col_idx]
        dr = rs + jnp.arange(kh) - r + (KH_MAX - 1)
        bias = rpb[:, dr[:, None, None], dc[None]]
        bias = bias.transpose(0, 2, 1, 3).astype(jnp.float32)
        s = jnp.einsum('bqhd,brqwhd->bhqrw', q_r, k_w).astype(jnp.float32) * scale + bias[None]
        p = jax.nn.softmax(s.reshape(B, H_A, GRID_W, kh * KW), axis=-1)
        p = p.reshape(B, H_A, GRID_W, kh, KW).astype(v.dtype)
        return jnp.einsum('bhqrw,brqwhd->bqhd', p, v_w)

    out = lax.map(row_step, jnp.arange(rows))
    return out.transpose(1, 0, 2, 3, 4).reshape(B, T, D_A)


def sliding_window_attention(q, k, v, sinks):
    B, T = q.shape[0], q.shape[1]
    nb = T // BLOCK
    scale = 1.0 / math.sqrt(HEAD_DIM)
    slopes = jnp.exp2(-8.0 * jnp.arange(1, H_B + 1, dtype=jnp.float32) / H_B)
    slope = slopes.reshape(H_KV, GROUP)[None, :, :, None, None]
    sink = sinks.astype(jnp.float32).reshape(H_KV, GROUP)[None, :, :, None]
    q = q.reshape(B, nb, BLOCK, H_KV, GROUP, HEAD_DIM)
    pad = ((0, 0), (BLOCK, BLOCK), (0, 0), (0, 0))
    kp = jnp.pad(k, pad)
    vp = jnp.pad(v, pad)

    def block_step(i):
        q_i = lax.dynamic_index_in_dim(q, i, axis=1, keepdims=False)
        k_i = lax.dynamic_slice_in_dim(kp, i * BLOCK, 3 * BLOCK, axis=1)
        v_i = lax.dynamic_slice_in_dim(vp, i * BLOCK, 3 * BLOCK, axis=1)
        t = i * BLOCK + jnp.arange(BLOCK)
        s_pos = (i - 1) * BLOCK + jnp.arange(3 * BLOCK)
        dist = jnp.abs(t[:, None] - s_pos[None, :])
        valid = (dist <= WINDOW) & (s_pos >= 0)[None, :] & (s_pos < T)[None, :]
        logits = jnp.einsum('bqkgd,bskd->bkgqs', q_i, k_i).astype(jnp.float32) * scale
        logits = logits - slope * dist.astype(jnp.float32)
        logits = jnp.where(valid, logits, -jnp.inf)
        m = jnp.maximum(jnp.max(logits, axis=-1), sink)
        e = jnp.exp(logits - m[..., None])
        denom = jnp.sum(e, axis=-1) + jnp.exp(sink - m)
        p = (e / denom[..., None]).astype(v.dtype)
        return jnp.einsum('bkgqs,bskd->bqkgd', p, v_i).reshape(B, BLOCK, D_B)

    out = lax.map(block_step, jnp.arange(nb))
    return out.transpose(1, 0, 2, 3).reshape(B, T, D_B)


def dwconv3(u, w, b):
    up = jnp.pad(u, ((0, 0), (1, 1), (0, 0)))
    return up[:, :-2] * w[0] + up[:, 1:-1] * w[1] + up[:, 2:] * w[2] + b


def trunk(x, norm_mix, w_in, rpb, sinks, norm_grp, w_out, norm_ffn, w_up, conv_w, conv_b, w_down, norm_final):
    B, T = x.shape[0], x.shape[1]
    for l in range(DEPTH):
        h = rmsnorm(x, norm_mix[l])
        proj = h @ w_in[l]
        o = 0
        qa = proj[..., o:o + D_A].reshape(B, T, H_A, HEAD_DIM); o += D_A
        ka = proj[..., o:o + D_A].reshape(B, T, H_A, HEAD_DIM); o += D_A
        va = proj[..., o:o + D_A].reshape(B, T, H_A, HEAD_DIM); o += D_A
        qb = proj[..., o:o + D_B].reshape(B, T, H_B, HEAD_DIM); o += D_B
        kb = proj[..., o:o + D_KV].reshape(B, T, H_KV, HEAD_DIM); o += D_KV
        vb = proj[..., o:o + D_KV].reshape(B, T, H_KV, HEAD_DIM)
        out_a = neighbourhood_attention(qa, ka, va, rpb[l])
        out_b = sliding_window_attention(qb, kb, vb, sinks[l])
        out_a = rmsnorm(out_a, norm_grp[l, :D_A])
        out_b = rmsnorm(out_b, norm_grp[l, D_A:])
        x = x + jnp.concatenate([out_a, out_b], axis=-1) @ w_out[l]
        h = rmsnorm(x, norm_ffn[l])
        u = dwconv3(h @ w_up[l], conv_w[l], conv_b[l])
        gate, val = u[..., :D_FF], u[..., D_FF:]
        x = x + (jax.nn.silu(gate) * val) @ w_down[l]
    return rmsnorm(x, norm_final)


def setup_inputs(seed: int = 0) -> dict:
    key = jax.random.key(seed)
    ks = jax.random.split(key, 16)
    f32 = jnp.float32
    nrm = lambda k, shape, s: jax.random.normal(k, shape, f32) * s
    return {
        "x_prompt": nrm(ks[0], (BATCH, SEQ, D_MODEL), 1.0),
        "x_sample": nrm(ks[1], (DEC_BATCH, DEC_SEQ, D_MODEL), 1.0),
        "norm_mix": 1.0 + nrm(ks[2], (DEPTH, D_MODEL), 0.02),
        "w_in": nrm(ks[3], (DEPTH, D_MODEL, W_IN_COLS), D_MODEL ** -0.5),
        "rpb": nrm(ks[4], (DEPTH, H_A, 2 * KH_MAX - 1, 2 * KW - 1), 0.5),
        "sinks": nrm(ks[5], (DEPTH, H_B), 0.5),
        "norm_grp": 1.0 + nrm(ks[6], (DEPTH, D_MIX), 0.02),
        "w_out": nrm(ks[7], (DEPTH, D_MIX, D_MODEL), D_MIX ** -0.5),
        "norm_ffn": 1.0 + nrm(ks[8], (DEPTH, D_MODEL), 0.02),
        "w_up": nrm(ks[9], (DEPTH, D_MODEL, 2 * D_FF), D_MODEL ** -0.5),
        "conv_w": nrm(ks[10], (DEPTH, CONV_W, 2 * D_FF), CONV_W ** -0.5),
        "conv_b": nrm(ks[11], (DEPTH, 2 * D_FF), 0.02),
        "w_down": nrm(ks[12], (DEPTH, D_FF, D_MODEL), D_FF ** -0.5),
        "norm_final": 1.0 + nrm(ks[13], (D_MODEL,), 0.02),
    }


def reference(x_prompt, x_sample, norm_mix, w_in, rpb, sinks, norm_grp, w_out, norm_ffn, w_up, conv_w, conv_b, w_down, norm_final):
    y_prompt = trunk(x_prompt, norm_mix, w_in, rpb, sinks, norm_grp, w_out, norm_ffn, w_up, conv_w, conv_b, w_down, norm_final)
    y_sample = trunk(x_sample, norm_mix, w_in, rpb, sinks, norm_grp, w_out, norm_ffn, w_up, conv_w, conv_b, w_down, norm_final)
    return (y_prompt, y_sample)
```

```cpp
#include <hip/hip_runtime.h>
#include <cstdio>
#include <cstdint>

#ifndef MK_N_LAUNCHES
#define MK_N_LAUNCHES 1
#endif

#ifndef REP_MASK
#define REP_MASK 0
#endif
#define LAS __attribute__((address_space(3)))
#define GAS __attribute__((address_space(1)))
typedef unsigned short bf16_t;
typedef short bf16x8 __attribute__((ext_vector_type(8)));
typedef short s16x4 __attribute__((ext_vector_type(4)));
typedef float f32x2 __attribute__((ext_vector_type(2)));
typedef float f32x4 __attribute__((ext_vector_type(4)));
typedef float f32x16 __attribute__((ext_vector_type(16)));
typedef unsigned u32x2 __attribute__((ext_vector_type(2)));
typedef unsigned u32x4 __attribute__((ext_vector_type(4)));
typedef __bf16 bf16x2_t __attribute__((ext_vector_type(2)));

constexpr int SEQ = 16384, NSEQ = 3, M = NSEQ * SEQ;
constexpr int D = 1024, NIN = 2304, DFF = 2816, NUP = 2 * DFF, DEPTH = 2;
constexpr int COL_QA = 0, COL_KA = 512, COL_VA = 1024, COL_QB = 1536, COL_KB = 2048, COL_VB = 2176;
constexpr float EPS = 1e-6f;
constexpr float LOG2E = 1.4426950408889634f;
constexpr float C2 = 0.125f * LOG2E;
#ifndef UP_WGM
#define UP_WGM 8
#endif
constexpr int UPM = 252;
constexpr int MP = M + NSEQ - 1;
constexpr int UP_NM = (MP + UPM - 1) / UPM;

constexpr size_t MiB = 1u << 20;
constexpr size_t WS_CTL = 0, CTL_ZERO_BYTES = 128 * 1024;
constexpr size_t W_IN_B = (size_t)NIN * D * 2, W_OUT_B = (size_t)D * D * 2, W_UP_B = (size_t)NUP * D * 2, W_DN_B = (size_t)D * DFF * 2;
constexpr size_t WS_W = 1 * MiB, W_LAYER_B = W_IN_B + W_OUT_B + W_UP_B + W_DN_B;
constexpr size_t WS_XB = 48 * MiB + 4096;
constexpr size_t WS_SSX = 146 * MiB, WS_SSA = 149 * MiB;
constexpr size_t WS_PROJ = 152 * MiB;
constexpr size_t WS_ATT = 368 * MiB;
constexpr size_t WS_HID = 152 * MiB;
constexpr size_t WS_END = 464 * MiB;
static_assert(WS_W + DEPTH * W_LAYER_B <= 48 * MiB && WS_XB + (size_t)(MP + 300) * D * 2 <= WS_SSX && WS_SSX + (size_t)M * 64 <= WS_SSA && WS_SSA + (size_t)M * 64 <= WS_PROJ, "ws map");
static_assert(WS_PROJ + (size_t)M * NIN * 2 <= WS_ATT && WS_ATT + (size_t)M * D * 2 <= WS_END && WS_HID + (size_t)M * DFF * 2 <= WS_END, "ws map");
constexpr int CW_BAR = 1024;
constexpr int CW_CNT = 4608;
constexpr size_t WS_XSLOT = 47 * MiB;
#ifndef FUSE_FINAL
#define FUSE_FINAL 1
#endif

constexpr int RING_BYTES = 131072;
constexpr int MISC_OFF = RING_BYTES;
constexpr int TAB_OFF = RING_BYTES + 1024;
constexpr int TAB_BYTES = 26 * 1024;
constexpr int LDS_BYTES = TAB_OFF + TAB_BYTES;
constexpr int NWAVES = 8;

__device__ __forceinline__ unsigned cvtpk(float lo, float hi) { f32x2 v = {lo, hi}; bf16x2_t b = __builtin_convertvector(v, bf16x2_t); return __builtin_bit_cast(unsigned, b); }
__device__ __forceinline__ float wave_sum(float v) {
#pragma unroll
    for (int o = 1; o < 64; o <<= 1) v += __shfl_xor(v, o);
    return v;
}
__device__ __forceinline__ float dpp_shr1(float x) { return __int_as_float(__builtin_amdgcn_update_dpp(0, __float_as_int(x), 0x111, 0xf, 0xf, true)); }
__device__ __forceinline__ float dpp_shl1(float x) { return __int_as_float(__builtin_amdgcn_update_dpp(0, __float_as_int(x), 0x101, 0xf, 0xf, true)); }
__device__ __forceinline__ float swap_max(float v) { auto rr = __builtin_amdgcn_permlane32_swap(__float_as_uint(v), __float_as_uint(v), false, false); return fmaxf(__uint_as_float(rr[0]), __uint_as_float(rr[1])); }
__device__ __forceinline__ float swap_sum(float v) { auto rr = __builtin_amdgcn_permlane32_swap(__float_as_uint(v), __float_as_uint(v), false, false); return __uint_as_float(rr[0]) + __uint_as_float(rr[1]); }
#define LDS_WAIT() asm volatile("s_waitcnt lgkmcnt(0)" ::: "memory")
__device__ __forceinline__ void glds16(const void* gsrc, unsigned lds_dst) { unsigned keep;
    asm volatile("s_mov_b32 %0, m0\n\ts_mov_b32 m0, %2\n\ts_nop 0\n\tglobal_load_lds_dwordx4 %1, off\n\ts_mov_b32 m0, %0" : "=&s"(keep) : "v"(gsrc), "s"(lds_dst) : "memory"); }
#define VM_WAIT() asm volatile("s_waitcnt vmcnt(0)" ::: "memory")

namespace pg8 {
constexpr int BM = 256, BK = 64, HALF = 128, HTB = HALF * BK * 2, NXCD = 8, WGM = 8;
__host__ __device__ __forceinline__ int lds_byte(int r, int c) { const int st = (r >> 4) * 2 + (c >> 5), rr = r & 15, cc = c & 31, ob = rr * 64 + cc * 2; return st * 1024 + (ob ^ (((ob >> 9) & 1) << 5)); }
__host__ __device__ __forceinline__ void stage_rc(int b, int& R, int& C) { const int st = b / 1024, sb = b % 1024, swz = sb ^ (((sb >> 9) & 1) << 5); R = (st >> 1) * 16 + swz / 64; C = (st & 1) * 32 + (swz % 64) / 2; }
__host__ __device__ __forceinline__ int perm32(int rho) { const int n = rho >> 4, i = rho & 15; return 8 * (i >> 2) + 4 * n + (i & 3); }

struct Unit { int pm, pn; };
struct Gemm { const char* A; const char* Bt; int K; long a_tstep, a_hstep, b_tstep, b_hstep; int amap; long a_pad; };

struct StaticOrder {
    int nM, nN, nwg, G, c, wgm, rev;
    __device__ void init(int nM_, int nN_, int G_, int c_, int wgm_ = WGM, int rev_ = 0) { nM = nM_; nN = nN_; nwg = nM * nN; G = G_; c = c_; wgm = wgm_; rev = rev_; }
    __device__ bool next(int i, Unit& u) const {
        const long L = (long)i * G + c; if (L >= nwg) return false;
        int wgid = (int)L; { const int q = nwg / NXCD, r = nwg % NXCD, xcd = wgid % NXCD, off = wgid / NXCD; wgid = (xcd < r ? xcd * (q + 1) : r * (q + 1) + (xcd - r) * q) + off; }
        const int nig = wgm * nN, gid = wgid / nig, fm = gid * wgm, gsz = (nM - fm) < wgm ? (nM - fm) : wgm;
        u.pm = fm + ((wgid % nig) % gsz); u.pn = (wgid % nig) / gsz; if (rev) u.pm = nM - 1 - u.pm; return true;
    }
};

template <class Epi, bool ALIGN_EPI>
__device__ __forceinline__ void gemm_phase(LAS unsigned char* lds, const Gemm g, const StaticOrder& S, const Epi& E) {
    int tid_ = threadIdx.x; asm volatile("" : "+v"(tid_));
    const int tid = tid_, wid = __builtin_amdgcn_readfirstlane(tid >> 6), lane = tid & 63, wr = wid >> 2, wc = wid & 3, fr = lane & 15, fq = lane >> 4;
    const int K = g.K, nt = K / BK;
    unsigned voffA[2], voffB[2];
#pragma unroll
    for (int i = 0; i < 2; ++i) { int R, C; stage_rc(tid * 16 + i * 8192, R, C); const int Rb = (R & ~31) + perm32(R & 31);
        const int Ra = g.amap ? (126 * (R >> 6) + 8 * (R & 15) + ((R >> 4) & 3)) : R;
        voffA[i] = (unsigned)(Ra * K + C) * 2u; voffB[i] = (unsigned)(Rb * K + C) * 2u; }
    const size_t kstep = (size_t)(BK * 2);
    const size_t ahs = (size_t)g.a_hstep, bhs = (size_t)g.b_hstep;
    const unsigned ldsw = (unsigned)wid * 1024u;
    const int aoff = lds_byte(wr * 64 + fr, fq * 8), boff = lds_byte(wc * 32 + fr, fq * 8);
#define PG8_SA(b, h) (((b) * 2 + (h)) * HTB)
#define PG8_SB(b, h) ((4 + (b) * 2 + (h)) * HTB)
#define PG8_STAGE(bufoff, gbase, voff) do { _Pragma("unroll") for (int _i = 0; _i < 2; ++_i) \
        __builtin_amdgcn_global_load_lds((const unsigned*)((const char*)(gbase) + (voff)[_i]), (LAS unsigned*)(lds + (bufoff) + ldsw + _i * 8192), 16, 0, 0); } while (0)
#define PG8_LDA(dst, b, h) do { _Pragma("unroll") for (int m = 0; m < 4; ++m) _Pragma("unroll") for (int k = 0; k < 2; ++k) dst[m][k] = *(const LAS bf16x8*)(lds + PG8_SA(b, h) + aoff + m * 2048 + k * 1024); } while (0)
#define PG8_LDB(dst, b, h) do { _Pragma("unroll") for (int n = 0; n < 2; ++n) _Pragma("unroll") for (int k = 0; k < 2; ++k) dst[n][k] = *(const LAS bf16x8*)(lds + PG8_SB(b, h) + boff + n * 2048 + k * 1024); } while (0)
#define PG8_MMA(ai, bj, At, Bt) do { __builtin_amdgcn_s_setprio(1); _Pragma("unroll") for (int m = 0; m < 4; ++m) _Pragma("unroll") for (int n = 0; n < 2; ++n) _Pragma("unroll") for (int k = 0; k < 2; ++k) \
        acc[ai][bj][m][n] = __builtin_amdgcn_mfma_f32_16x16x32_bf16(Bt[n][k], At[m][k], acc[ai][bj][m][n], 0, 0, 0); __builtin_amdgcn_s_setprio(0); } while (0)
#define PG8_WAIT_V(n) asm volatile("s_waitcnt vmcnt(" #n ")" ::: "memory")
#define PG8_WAIT_L(n) asm volatile("s_waitcnt lgkmcnt(" #n ")" ::: "memory")
#define PG8_BAR __builtin_amdgcn_s_barrier()
#define PG8_SCHED __builtin_amdgcn_sched_barrier(0)
    Unit cur, nxt; int ui = 0;
    if (!S.next(0, cur)) return;
    f32x4 acc[2][2][4][2];
#pragma unroll
    for (int a = 0; a < 2; ++a)
#pragma unroll
        for (int b = 0; b < 2; ++b)
#pragma unroll
            for (int m = 0; m < 4; ++m)
#pragma unroll
                for (int n = 0; n < 2; ++n) acc[a][b][m][n] = (f32x4){0.f, 0.f, 0.f, 0.f};
    bf16x8 At[4][2], B0[2][2], B1[2][2];
    const char* cA = g.A + (size_t)cur.pm * g.a_tstep + (size_t)(cur.pm >> 6) * g.a_pad; const char* cB = g.Bt + (size_t)cur.pn * g.b_tstep;
    if constexpr (Epi::HOOK) E.unit_start(cur, ui, wid, lane);
    PG8_STAGE(PG8_SB(0, 0), cB, voffB); PG8_STAGE(PG8_SB(0, 1), cB + bhs, voffB); PG8_STAGE(PG8_SA(0, 0), cA, voffA); PG8_STAGE(PG8_SA(0, 1), cA + ahs, voffA);
    if (wr == 1) PG8_BAR;
    PG8_WAIT_V(2); PG8_BAR;
    PG8_STAGE(PG8_SB(1, 0), cB + kstep, voffB); PG8_STAGE(PG8_SA(1, 0), cA + kstep, voffA); PG8_STAGE(PG8_SB(1, 1), cB + bhs + kstep, voffB);
    PG8_WAIT_V(6); PG8_BAR;
    for (;;) {
        const bool has_next = S.next(ui + 1, nxt);
        const char* nA = has_next ? g.A + (size_t)nxt.pm * g.a_tstep + (size_t)(nxt.pm >> 6) * g.a_pad : cA; const char* nB = has_next ? g.Bt + (size_t)nxt.pn * g.b_tstep : cB;
        for (int th = 0; th < nt; th += (Epi::MIDK ? nt / 2 : nt)) {
        if constexpr (Epi::MIDK) { if (th) E.midk(acc, ui, wr, fr); }
        for (int t = th; t < th + (Epi::MIDK ? nt / 2 : nt); t += 2) {
            const bool last = (t == nt - 2);
            const char* a1 = cA + (size_t)(t + 1) * kstep;
            const char* a2 = last ? nA : cA + (size_t)(t + 2) * kstep; const char* b2 = last ? nB : cB + (size_t)(t + 2) * kstep;
            const char* a3 = a2 + kstep; const char* b3 = b2 + kstep;
            PG8_LDB(B0, 0, 0); PG8_LDB(B1, 0, 1); PG8_SCHED; PG8_LDA(At, 0, 0); PG8_STAGE(PG8_SA(1, 1), a1 + ahs, voffA);
            PG8_WAIT_V(8); PG8_WAIT_L(0); PG8_BAR; PG8_MMA(0, 0, At, B0); PG8_MMA(0, 1, At, B1); PG8_BAR; PG8_SCHED;
            PG8_LDA(At, 0, 1); PG8_STAGE(PG8_SB(0, 0), b2, voffB); PG8_STAGE(PG8_SB(0, 1), b2 + bhs, voffB); PG8_STAGE(PG8_SA(0, 0), a2, voffA);
            PG8_WAIT_V(8); PG8_WAIT_L(0); PG8_BAR; PG8_MMA(1, 0, At, B0); PG8_MMA(1, 1, At, B1); PG8_BAR; PG8_SCHED;
            PG8_LDB(B0, 1, 0); PG8_LDB(B1, 1, 1); PG8_SCHED; PG8_LDA(At, 1, 0); PG8_STAGE(PG8_SA(0, 1), a2 + ahs, voffA);
            PG8_WAIT_V(8); PG8_WAIT_L(0); PG8_BAR; PG8_MMA(0, 0, At, B0); PG8_MMA(0, 1, At, B1); PG8_BAR; PG8_SCHED;
            PG8_LDA(At, 1, 1); PG8_STAGE(PG8_SB(1, 0), b3, voffB); PG8_STAGE(PG8_SB(1, 1), b3 + bhs, voffB); PG8_STAGE(PG8_SA(1, 0), a3, voffA);
            PG8_WAIT_V(8); PG8_WAIT_L(0); PG8_BAR; PG8_MMA(1, 0, At, B0); PG8_MMA(1, 1, At, B1); PG8_BAR; PG8_SCHED;
        }
        }
        if constexpr (ALIGN_EPI) { if (wr == 0) PG8_BAR; }
        E(acc, cur, ui, wr, wc, fr, fq);
        if (!has_next) break;
#pragma unroll
        for (int a = 0; a < 2; ++a)
#pragma unroll
            for (int b = 0; b < 2; ++b)
#pragma unroll
                for (int m = 0; m < 4; ++m)
#pragma unroll
                    for (int n = 0; n < 2; ++n) acc[a][b][m][n] = (f32x4){0.f, 0.f, 0.f, 0.f};
        cur = nxt; cA = nA; cB = nB; ++ui;
        if constexpr (Epi::HOOK) E.unit_start(cur, ui, wid, lane);
        if constexpr (ALIGN_EPI) { if (wr == 1) PG8_BAR; }
    }
    PG8_WAIT_V(0);
    if constexpr (!ALIGN_EPI) { if (wr == 0) PG8_BAR; }
    PG8_BAR;
#undef PG8_SA
#undef PG8_SB
#undef PG8_STAGE
#undef PG8_LDA
#undef PG8_LDB
#undef PG8_MMA
#undef PG8_WAIT_V
#undef PG8_WAIT_L
#undef PG8_BAR
#undef PG8_SCHED
}

struct EpiProj {
    static constexpr bool MIDK = false, HOOK = false;
    bf16_t* O; const LAS float* rs;
    __device__ __forceinline__ void operator()(const f32x4 (&acc)[2][2][4][2], const Unit& u, int ui, int wr, int wc, int fr, int fq) const {
        const float sct = (u.pn < 2 || u.pn == 6 || u.pn == 7) ? C2 : 1.0f;
        const LAS float* rsu = rs + ui * 256;
#pragma unroll
        for (int ai = 0; ai < 2; ++ai)
#pragma unroll
            for (int m = 0; m < 4; ++m) { const int row = ai * HALF + wr * 64 + m * 16 + fr; const float sc = rsu[row] * sct;
                bf16_t* rowp = O + (size_t)(u.pm * BM + row) * NIN + u.pn * BM + wc * 32 + 8 * fq;
#pragma unroll
                for (int bj = 0; bj < 2; ++bj) { const f32x4 v0 = acc[ai][bj][m][0] * sc, v1 = acc[ai][bj][m][1] * sc;
                    u32x4 w; w.x = cvtpk(v0[0], v0[1]); w.y = cvtpk(v0[2], v0[3]); w.z = cvtpk(v1[0], v1[1]); w.w = cvtpk(v1[2], v1[3]);
                    *(u32x4*)(rowp + bj * HALF) = w; } }
    }
};
__device__ __forceinline__ float bf_lo(unsigned w) { return __uint_as_float(w << 16); }
__device__ __forceinline__ float bf_hi(unsigned w) { return __uint_as_float(w & 0xffff0000u); }
template <bool GRP> struct EpiRes {
    static constexpr bool MIDK = GRP, HOOK = false;
    bf16_t* xb; float* ssx; const LAS f32x2* rs2;
    __device__ __forceinline__ void midk(f32x4 (&acc)[2][2][4][2], int ui, int wr, int fr) const {
        const LAS f32x2* rsu = rs2 + ui * 256;
#pragma unroll
        for (int ai = 0; ai < 2; ++ai)
#pragma unroll
            for (int m = 0; m < 4; ++m) { const float ra = rsu[ai * HALF + wr * 64 + m * 16 + fr].x;
#pragma unroll
                for (int bj = 0; bj < 2; ++bj)
#pragma unroll
                    for (int n = 0; n < 2; ++n) acc[ai][bj][m][n] *= ra; }
    }
    __device__ __forceinline__ void operator()(const f32x4 (&acc)[2][2][4][2], const Unit& u, int ui, int wr, int wc, int fr, int fq) const {
        const int row0 = wr * 64 + fr, col0 = u.pn * BM + wc * 32 + 8 * fq;
        GAS bf16_t* xp0 = (GAS bf16_t*)xb + (size_t)(u.pm * BM + (u.pm >> 6) + row0) * D + col0;
        GAS float* sp = (GAS float*)ssx + (size_t)(u.pm * BM + row0) * 16 + u.pn * 4 + wc;
        const LAS f32x2* rsu = rs2 + ui * 256 + row0;
        u32x4 rw[2][4][2];
#pragma unroll
        for (int ai = 0; ai < 2; ++ai)
#pragma unroll
            for (int m = 0; m < 4; ++m)
#pragma unroll
                for (int bj = 0; bj < 2; ++bj) rw[ai][m][bj] = *(const GAS u32x4*)(xp0 + (size_t)(ai * HALF + m * 16) * D + bj * HALF);
        GAS bf16_t* xp = xp0;
#pragma unroll
        for (int ai = 0; ai < 2; ++ai)
#pragma unroll
            for (int m = 0; m < 4; ++m) {
                float sc = 1.0f; if constexpr (GRP) sc = rsu[ai * HALF + m * 16].y;
                float ss = 0.f;
#pragma unroll
                for (int bj = 0; bj < 2; ++bj) {
                    const u32x4 r = rw[ai][m][bj];
                    const f32x4 r0 = (f32x4){bf_lo(r.x), bf_hi(r.x), bf_lo(r.y), bf_hi(r.y)}, r1 = (f32x4){bf_lo(r.z), bf_hi(r.z), bf_lo(r.w), bf_hi(r.w)};
                    const f32x4 v0 = r0 + acc[ai][bj][m][0] * sc, v1 = r1 + acc[ai][bj][m][1] * sc;
                    u32x4 w; w.x = cvtpk(v0[0], v0[1]); w.y = cvtpk(v0[2], v0[3]); w.z = cvtpk(v1[0], v1[1]); w.w = cvtpk(v1[2], v1[3]);
                    *(GAS u32x4*)(xp + bj * HALF) = w;
                    ss += (v0[0] * v0[0] + v0[1] * v0[1]) + (v0[2] * v0[2] + v0[3] * v0[3]) + (v1[0] * v1[0] + v1[1] * v1[1]) + (v1[2] * v1[2] + v1[3] * v1[3]); }
                ss += __shfl_xor(ss, 16); ss += __shfl_xor(ss, 32);
                if (fq == 0) *sp = ss;
                const int adv = (m == 3) ? (HALF - 48) : 16;
                xp += (size_t)adv * D; sp += adv * 16;
                asm volatile("" : "+v"(xp), "+v"(sp)); }
    }
};
struct EpiFin {
    static constexpr bool MIDK = false, HOOK = false;
    const bf16_t* xb; float* out; const float* gfin; float* xslot; unsigned* cnt; LAS unsigned char* scr;
    __device__ __forceinline__ void operator()(f32x4 (&acc)[2][2][4][2], const Unit& u, int ui, int wr, int wc, int fr, int fq) const {
        const int tid = threadIdx.x, lane = tid & 63;
        const int row0 = wr * 64 + fr, col0 = u.pn * BM + wc * 32 + 8 * fq;
        const GAS bf16_t* xp0 = (const GAS bf16_t*)xb + (size_t)(u.pm * BM + (u.pm >> 6) + row0) * D + col0;
        LAS float* P = (LAS float*)scr; LAS float* S = (LAS float*)(scr + 4096); volatile LAS unsigned* flag = (volatile LAS unsigned*)(scr + 5120);
        u32x4 rw[2][4][2];
#pragma unroll
        for (int ai = 0; ai < 2; ++ai)
#pragma unroll
            for (int m = 0; m < 4; ++m)
#pragma unroll
                for (int bj = 0; bj < 2; ++bj) rw[ai][m][bj] = *(const GAS u32x4*)(xp0 + (size_t)(ai * HALF + m * 16) * D + bj * HALF);
#pragma unroll
        for (int ai = 0; ai < 2; ++ai)
#pragma unroll
            for (int m = 0; m < 4; ++m) { float ss = 0.f;
#pragma unroll
                for (int bj = 0; bj < 2; ++bj) { const u32x4 r = rw[ai][m][bj];
                    acc[ai][bj][m][0] += (f32x4){bf_lo(r.x), bf_hi(r.x), bf_lo(r.y), bf_hi(r.y)}; acc[ai][bj][m][1] += (f32x4){bf_lo(r.z), bf_hi(r.z), bf_lo(r.w), bf_hi(r.w)};
                    const f32x4 v0 = acc[ai][bj][m][0], v1 = acc[ai][bj][m][1];
                    ss += (v0[0] * v0[0] + v0[1] * v0[1]) + (v0[2] * v0[2] + v0[3] * v0[3]) + (v1[0] * v1[0] + v1[1] * v1[1]) + (v1[2] * v1[2] + v1[3] * v1[3]); }
                ss += __shfl_xor(ss, 16); ss += __shfl_xor(ss, 32);
                if (fq == 0) P[(ai * HALF + row0 + m * 16) * 4 + wc] = ss; }
        asm volatile("s_waitcnt lgkmcnt(0)" ::: "memory"); __builtin_amdgcn_s_barrier(); asm volatile("" ::: "memory");
        GAS float* slot = (GAS float*)xslot + ((size_t)u.pm * 256) * 4;
        if (tid < 256) { const f32x4 p = *(const LAS f32x4*)(P + tid * 4);
            __hip_atomic_store(slot + tid * 4 + u.pn, (p[0] + p[1]) + (p[2] + p[3]), __ATOMIC_RELAXED, __HIP_MEMORY_SCOPE_AGENT); }
        asm volatile("s_waitcnt vmcnt(0)" ::: "memory"); __builtin_amdgcn_s_barrier(); asm volatile("" ::: "memory");
        if (tid == 0) {
            __hip_atomic_fetch_add(cnt + 64 * u.pm, 1u, __ATOMIC_RELAXED, __HIP_MEMORY_SCOPE_AGENT);
            unsigned sp = 0, ok = 1;
            while (__hip_atomic_load(cnt + 64 * u.pm, __ATOMIC_RELAXED, __HIP_MEMORY_SCOPE_AGENT) < 4u) { __builtin_amdgcn_s_sleep(2); if (++sp > (1u << 22)) { ok = 0; break; } }
            __builtin_amdgcn_fence(__ATOMIC_ACQUIRE, "agent");
            flag[0] = ok;
        }
        asm volatile("s_waitcnt vmcnt(0) lgkmcnt(0)" ::: "memory"); __builtin_amdgcn_s_barrier(); asm volatile("" ::: "memory");
        if (tid < 256) { float t = 0.f;
#pragma unroll
            for (int k = 0; k < 4; ++k) t += __hip_atomic_load(slot + tid * 4 + k, __ATOMIC_RELAXED, __HIP_MEMORY_SCOPE_AGENT);
            S[tid] = (flag[0] != 0u) ? 1.0f / sqrtf(t * (1.0f / D) + EPS) : __builtin_nanf(""); }
        asm volatile("s_waitcnt vmcnt(0) lgkmcnt(0)" ::: "memory"); __builtin_amdgcn_s_barrier(); asm volatile("" ::: "memory");
        f32x4 g0[2], g1[2];
#pragma unroll
        for (int bj = 0; bj < 2; ++bj) { g0[bj] = *(const GAS f32x4*)((const GAS float*)gfin + col0 + bj * HALF); g1[bj] = *(const GAS f32x4*)((const GAS float*)gfin + col0 + bj * HALF + 4); }
        GAS float* op = (GAS float*)out + (size_t)(u.pm * BM + row0) * D + col0;
#pragma unroll
        for (int ai = 0; ai < 2; ++ai)
#pragma unroll
            for (int m = 0; m < 4; ++m) { const float iv = S[ai * HALF + row0 + m * 16];
#pragma unroll
                for (int bj = 0; bj < 2; ++bj) { *(GAS f32x4*)(op + bj * HALF) = acc[ai][bj][m][0] * iv * g0[bj]; *(GAS f32x4*)(op + bj * HALF + 4) = acc[ai][bj][m][1] * iv * g1[bj]; }
                const int adv = (m == 3) ? (HALF - 48) : 16; op += (size_t)adv * D; asm volatile("" : "+v"(op)); }
        asm volatile("s_waitcnt lgkmcnt(0)" ::: "memory"); __builtin_amdgcn_s_barrier(); asm volatile("" ::: "memory");
        (void)lane;
    }
};
struct EpiUp {
    static constexpr bool MIDK = false, HOOK = true;
    bf16_t* hid; const float* cw; const float* cb; const LAS float* rs; LAS unsigned char* cbuf;
    __device__ __forceinline__ void unit_start(const Unit& u, int ui, int wid, int lane) const {
        if (wid < 4) { const int a = 2 * wid + (lane >> 5);
            const float* src = ((a & 3) < 3 ? cw + (size_t)(a & 3) * NUP : cb) + (a >= 4 ? DFF : 0) + u.pn * HALF + (lane & 31) * 4;
            glds16(src, (unsigned)__builtin_amdgcn_readfirstlane((unsigned)(uintptr_t)cbuf + (unsigned)((ui & 1) * 4096 + wid * 1024))); }
    }
    __device__ __forceinline__ void operator()(const f32x4 (&acc)[2][2][4][2], const Unit& u, int ui, int wr, int wc, int fr, int fq) const {
        const LAS float* rsu = rs + ui * 256 + wr * 64 + fr;
        float inv[8];
#pragma unroll
        for (int q = 0; q < 8; ++q) inv[q] = rsu[(q >> 2) * HALF + (q & 3) * 16];
        const int p0 = UPM * u.pm - 1 + 126 * wr + 8 * fr;
        const int cg = u.pn * HALF + wc * 32 + 8 * fq;
#pragma unroll
        for (int n = 0; n < 2; ++n) {
            const int c0 = cg + 4 * n;
            const LAS float* wl = (const LAS float*)(cbuf + (ui & 1) * 4096) + wc * 32 + 8 * fq + 4 * n;
            const f32x4 w0g = *(const LAS f32x4*)(wl), w1g = *(const LAS f32x4*)(wl + 128), w2g = *(const LAS f32x4*)(wl + 256), bg = *(const LAS f32x4*)(wl + 384);
            const f32x4 w0v = *(const LAS f32x4*)(wl + 512), w1v = *(const LAS f32x4*)(wl + 640), w2v = *(const LAS f32x4*)(wl + 768), bv = *(const LAS f32x4*)(wl + 896);
            unsigned pk[8][2];
#pragma unroll
            for (int ep = 0; ep < 2; ++ep) {
                float rr[2][8];
#pragma unroll
                for (int e2 = 0; e2 < 2; ++e2) { const int e = 2 * ep + e2;
                    float xg[8], xv[8];
#pragma unroll
                    for (int q = 0; q < 8; ++q) { xg[q] = acc[q >> 2][0][q & 3][n][e] * inv[q]; xv[q] = acc[q >> 2][1][q & 3][n][e] * inv[q]; }
                    const float ug0 = dpp_shr1(xg[7]), uv0 = dpp_shr1(xv[7]), dg7 = dpp_shl1(xg[0]), dv7 = dpp_shl1(xv[0]);
#pragma unroll
                    for (int q = 0; q < 8; ++q) {
                        const float ug = q ? xg[q ? q - 1 : 0] : ug0, uv = q ? xv[q ? q - 1 : 0] : uv0, dg = (q < 7) ? xg[q < 7 ? q + 1 : 7] : dg7, dv = (q < 7) ? xv[q < 7 ? q + 1 : 7] : dv7;
                        const float gc = __builtin_fmaf(w0g[e], ug, __builtin_fmaf(w1g[e], xg[q], __builtin_fmaf(w2g[e], dg, bg[e])));
                        const float vc = __builtin_fmaf(w0v[e], uv, __builtin_fmaf(w1v[e], xv[q], __builtin_fmaf(w2v[e], dv, bv[e])));
                        const float sg = gc * __builtin_amdgcn_rcpf(1.0f + __builtin_amdgcn_exp2f(-LOG2E * gc));
                        rr[e2][q] = sg * vc; }
                }
#pragma unroll
                for (int q = 0; q < 8; ++q) pk[q][ep] = cvtpk(rr[0][q], rr[1][q]);
                __builtin_amdgcn_sched_barrier(0);
            }
#pragma unroll
            for (int q = 0; q < 8; ++q) { const int j = 8 * fr + q; int p = p0 + q; asm volatile("" : "+v"(p));
                const int tok = p - (p > SEQ ? 1 : 0) - (p > 2 * SEQ + 1 ? 1 : 0);
                if (j >= 1 && j <= 126 && p < MP && p != SEQ && p != 2 * SEQ + 1) { u32x2 w; w.x = pk[q][0]; w.y = pk[q][1]; *(GAS u32x2*)((GAS bf16_t*)hid + (size_t)tok * DFF + c0) = w; } }
            __builtin_amdgcn_sched_barrier(0);
        }
    }
};
}

namespace att {
constexpr int PITCH = NIN * 2;
constexpr int SLOT = 16384;
__device__ __forceinline__ float quad_max(float v) {
    auto a = __builtin_amdgcn_permlane16_swap(__float_as_uint(v), __float_as_uint(v), false, false); v = fmaxf(__uint_as_float(a[0]), __uint_as_float(a[1]));
    auto b = __builtin_amdgcn_permlane32_swap(__float_as_uint(v), __float_as_uint(v), false, false); return fmaxf(__uint_as_float(b[0]), __uint_as_float(b[1])); }
__device__ __forceinline__ float quad_sum(float v) {
    auto a = __builtin_amdgcn_permlane16_swap(__float_as_uint(v), __float_as_uint(v), false, false); v = __uint_as_float(a[0]) + __uint_as_float(a[1]);
    auto b = __builtin_amdgcn_permlane32_swap(__float_as_uint(v), __float_as_uint(v), false, false); return __uint_as_float(b[0]) + __uint_as_float(b[1]); }
#define WJ(j) ((j) == 0 ? 0 : (j) == 1 ? 8 : (j) == 2 ? 24 : 32)
template <int MODE>
__device__ __forceinline__ void block_unit(LAS unsigned char* ring, const bf16_t* proj, bf16_t* attn, float* ssa, int lane_, int wave,
                                           int ktok0, int nT, int kcol, int vcol, int act0, int actn,
                                           int qtok0, int half, int qcol, const LAS float* rpbh, int dr0, float slope2, float sink2, int outcol, int sscol) {
    int lane = lane_; asm volatile("" : "+v"(lane));
    const int qi = lane & 15, g = lane >> 4;
    const int rl = lane >> 3, cl = lane & 7;
    const char* kg = (const char*)(proj + (size_t)ktok0 * NIN + kcol) + (size_t)(8 * wave + rl) * PITCH + ((cl ^ ((4 * (wave & 1) + (lane >> 4)) & 7)) << 4);
    const char* vg = (const char*)(proj + (size_t)ktok0 * NIN + vcol) + (size_t)(8 * wave + rl) * PITCH + ((cl ^ (2 * (lane >> 4))) << 4);
    const unsigned ring0 = (unsigned)(uintptr_t)ring + (unsigned)wave * 1024u;
#define DMA_TILE(t) do { const unsigned sl_ = (unsigned)__builtin_amdgcn_readfirstlane(ring0 + (unsigned)((t) % 3) * SLOT); \
        glds16(kg + (size_t)(t) * 64 * PITCH, sl_); glds16(vg + (size_t)(t) * 64 * PITCH, sl_ + 8192u); } while (0)
    DMA_TILE(0); if (nT > 1) DMA_TILE(1);
    bf16x8 qf[2][2];
#pragma unroll
    for (int jj = 0; jj < 2; ++jj)
#pragma unroll
        for (int ks = 0; ks < 2; ++ks) qf[jj][ks] = *(const GAS bf16x8*)((const GAS bf16_t*)proj + (size_t)(qtok0 + 16 * jj + qi) * NIN + qcol + 32 * ks + 8 * g);
    __builtin_amdgcn_s_waitcnt(0x0F70);
    f32x4 o[2][4];
    float mrun[2], lrun[2];
#pragma unroll
    for (int jj = 0; jj < 2; ++jj) {
#pragma unroll
        for (int dt = 0; dt < 4; ++dt) o[jj][dt] = (f32x4){0.f, 0.f, 0.f, 0.f};
        mrun[jj] = (MODE == 1) ? sink2 : -1e30f; lrun[jj] = (MODE == 1 && g == 0) ? 1.0f : 0.0f; }
    const int va = (lane & 15) >> 2, vb = lane & 3, sv = (2 * (g & 1) + (va >> 1)) & 3;
    int kofs[2], kad[2][2], vad[2], relm[2], bofs[2];
#pragma unroll
    for (int jj = 0; jj < 2; ++jj) {
        const int j = 2 * half + jj; const int koff = (MODE == 1) ? 0 : ((j == 0) ? 0 : (j == 1) ? 8 : (j == 2) ? 24 : 32);
        const int par = (koff >> 3) & 1, s0 = g ^ (qi >> 1);
        kofs[jj] = koff;
        kad[jj][0] = (koff + qi) * 128 + ((s0 ^ (4 * par)) << 4); kad[jj][1] = (koff + qi) * 128 + ((s0 ^ (4 * par) ^ 4) << 4);
        vad[jj] = 8192 + (koff + 4 * g + va) * 128 + vb * 8;
        const int c = 16 * j + qi, cs = min(max(c - 8, 0), 48);
        relm[jj] = koff + 4 * g - cs; bofs[jj] = koff + 4 * g - c + 15; }
    const float NEG = -INFINITY;
    constexpr int NH = (MODE == 1) ? 2 : 1;
    for (int t = 0; t < nT; ++t) {
        if (t + 1 < nT) asm volatile("s_waitcnt vmcnt(2)" ::: "memory"); else asm volatile("s_waitcnt vmcnt(0)" ::: "memory");
        __builtin_amdgcn_s_barrier();
        if (t + 2 < nT) DMA_TILE(t + 2);
        if (t >= act0 && t < act0 + actn) {
        const LAS unsigned char* Sl = ring + (t % 3) * SLOT;
#pragma unroll
        for (int hf = 0; hf < NH; ++hf) {
            bf16x8 kf[2][2][2];
#pragma unroll
            for (int jj = 0; jj < 2; ++jj)
#pragma unroll
                for (int kt = 0; kt < 2; ++kt)
#pragma unroll
                    for (int ks = 0; ks < 2; ++ks) kf[jj][kt][ks] = *(const LAS bf16x8*)(Sl + kad[jj][ks] + (32 * hf + 16 * kt) * 128);
            float bb[2][2][4];
            if (MODE == 0) {
#pragma unroll
                for (int jj = 0; jj < 2; ++jj) { const LAS float* bl = rpbh + (dr0 + t - act0) * 32 + bofs[jj];
#pragma unroll
                    for (int kt = 0; kt < 2; ++kt)
#pragma unroll
                        for (int e = 0; e < 4; ++e) bb[jj][kt][e] = bl[16 * kt + e]; }
            }
            s16x4 vlo[2][4], vhi[2][4];
#pragma unroll
            for (int jj = 0; jj < 2; ++jj)
#pragma unroll
                for (int dt = 0; dt < 4; ++dt) { const LAS unsigned char* vp = Sl + vad[jj] + (32 * hf) * 128 + ((dt ^ sv) << 5);
                    vlo[jj][dt] = __builtin_bit_cast(s16x4, __builtin_amdgcn_ds_read_tr16_b64_v4i16((LAS s16x4*)(vp)));
                    vhi[jj][dt] = __builtin_bit_cast(s16x4, __builtin_amdgcn_ds_read_tr16_b64_v4i16((LAS s16x4*)(vp + 2048))); }
            __builtin_amdgcn_sched_barrier(0);
            f32x4 s[2][2];
#pragma unroll
            for (int jj = 0; jj < 2; ++jj)
#pragma unroll
                for (int kt = 0; kt < 2; ++kt) { f32x4 a = (f32x4){0.f, 0.f, 0.f, 0.f};
                    a = __builtin_amdgcn_mfma_f32_16x16x32_bf16(kf[jj][kt][0], qf[jj][0], a, 0, 0, 0);
                    s[jj][kt] = __builtin_amdgcn_mfma_f32_16x16x32_bf16(kf[jj][kt][1], qf[jj][1], a, 0, 0, 0); }
            if (MODE == 0) asm volatile("" : "+v"(bb[0][0][0]), "+v"(bb[0][0][1]), "+v"(bb[0][0][2]), "+v"(bb[0][0][3]), "+v"(bb[0][1][0]), "+v"(bb[0][1][1]), "+v"(bb[0][1][2]), "+v"(bb[0][1][3]),
                                            "+v"(bb[1][0][0]), "+v"(bb[1][0][1]), "+v"(bb[1][0][2]), "+v"(bb[1][0][3]), "+v"(bb[1][1][0]), "+v"(bb[1][1][1]), "+v"(bb[1][1][2]), "+v"(bb[1][1][3]));
            u32x4 pw[2];
#pragma unroll
            for (int jj = 0; jj < 2; ++jj) {
                if (MODE == 0) {
#pragma unroll
                    for (int kt = 0; kt < 2; ++kt)
#pragma unroll
                        for (int e = 0; e < 4; ++e) { const float v = s[jj][kt][e] + bb[jj][kt][e]; s[jj][kt][e] = ((unsigned)(relm[jj] + 16 * kt + e) < 16u) ? v : NEG; }
                } else {
                    const float dq = (float)((qtok0 + 16 * jj + qi) - (ktok0 + 64 * t + 32 * hf + 4 * g));
#pragma unroll
                    for (int kt = 0; kt < 2; ++kt)
#pragma unroll
                        for (int e = 0; e < 4; ++e) { const float dd = __builtin_fabsf(dq - (float)(16 * kt + e)); s[jj][kt][e] = (dd <= 128.f) ? s[jj][kt][e] - slope2 * dd : NEG; }
                }
                float tm = fmaxf(fmaxf(fmaxf(s[jj][0][0], s[jj][0][1]), fmaxf(s[jj][0][2], s[jj][0][3])), fmaxf(fmaxf(s[jj][1][0], s[jj][1][1]), fmaxf(s[jj][1][2], s[jj][1][3])));
                tm = quad_max(tm);
                const float mn = fmaxf(mrun[jj], tm);
                const float alpha = __builtin_amdgcn_exp2f(mrun[jj] - mn);
                mrun[jj] = mn;
                float rsum = 0.f;
#pragma unroll
                for (int kt = 0; kt < 2; ++kt)
#pragma unroll
                    for (int e = 0; e < 4; ++e) { s[jj][kt][e] = __builtin_amdgcn_exp2f(s[jj][kt][e] - mn); rsum += s[jj][kt][e]; }
                lrun[jj] = lrun[jj] * alpha + rsum;
#pragma unroll
                for (int dt = 0; dt < 4; ++dt) o[jj][dt] *= alpha;
                pw[jj].x = cvtpk(s[jj][0][0], s[jj][0][1]); pw[jj].y = cvtpk(s[jj][0][2], s[jj][0][3]); pw[jj].z = cvtpk(s[jj][1][0], s[jj][1][1]); pw[jj].w = cvtpk(s[jj][1][2], s[jj][1][3]);
            }
#pragma unroll
            for (int jj = 0; jj < 2; ++jj)
#pragma unroll
                for (int dt = 0; dt < 4; ++dt) {
                    const bf16x8 vf = (bf16x8){vlo[jj][dt][0], vlo[jj][dt][1], vlo[jj][dt][2], vlo[jj][dt][3], vhi[jj][dt][0], vhi[jj][dt][1], vhi[jj][dt][2], vhi[jj][dt][3]};
                    o[jj][dt] = __builtin_amdgcn_mfma_f32_16x16x32_bf16(vf, __builtin_bit_cast(bf16x8, pw[jj]), o[jj][dt], 0, 0, 0); }
            __builtin_amdgcn_sched_barrier(0);
        }
        }
    }
#undef DMA_TILE
    if (actn > 0) {
#pragma unroll
    for (int jj = 0; jj < 2; ++jj) {
        const float lt = quad_sum(lrun[jj]); const float il = 1.0f / lt;
        const int tok = qtok0 + 16 * jj + qi;
        float ss = 0.f;
#pragma unroll
        for (int dt = 0; dt < 4; ++dt) { const f32x4 v = o[jj][dt] * il;
            ss += (v[0] * v[0] + v[1] * v[1]) + (v[2] * v[2] + v[3] * v[3]);
            u32x2 w; w.x = cvtpk(v[0], v[1]); w.y = cvtpk(v[2], v[3]);
            *(GAS u32x2*)((GAS bf16_t*)attn + (size_t)tok * D + outcol + 16 * dt + 4 * g) = w; }
        ss = quad_sum(ss);
        if (g == 0) ((GAS float*)ssa)[(size_t)tok * 16 + sscol] = ss;
    }
    }
    __builtin_amdgcn_s_barrier();
}
#undef WJ
}

#define XB_TMO      128
#define XB_XCNT(j)  (256  + 64 * (j))
#define XB_XSUB(j)  (1280 + 64 * (j))
#define XB_XGEN(j)  (2304 + 64 * (j))
#define XB_TOP      3328
#define XB_TOPGEN   3392
#define XCD_BAR_WORDS 3456
#define XB_SPIN_CAP (1u << 20)
__device__ __forceinline__ unsigned xb_ld(unsigned* p)              { return __hip_atomic_load(p, __ATOMIC_RELAXED, __HIP_MEMORY_SCOPE_AGENT); }
__device__ __forceinline__ unsigned xb_add(unsigned* p, unsigned v) { return __hip_atomic_fetch_add(p, v, __ATOMIC_RELAXED, __HIP_MEMORY_SCOPE_AGENT); }
__device__ __forceinline__ unsigned xb_xcc_id() { return (unsigned)__builtin_amdgcn_s_getreg((3 << 11) | 20) & 0xFu; }
#define XB_SPIN(cond, bar) do { unsigned _sp = 0; while (cond) { __builtin_amdgcn_s_sleep(1); \
    if ((++_sp & 255u) == 0u) { if (xb_ld(&(bar)[XB_TMO])) break; if (_sp > XB_SPIN_CAP) { atomicAdd(&(bar)[XB_TMO], 1u); break; } } } } while (0)
struct XcdBarrier { unsigned* bar; unsigned x; volatile LAS unsigned* st; };
__device__ __forceinline__ XcdBarrier xcd_barrier_post(unsigned* bar, volatile LAS unsigned* st) {
    XcdBarrier b; b.bar = bar; b.x = xb_xcc_id(); b.st = st;
    if (threadIdx.x == 0) (void)xb_add(&bar[XB_XCNT(b.x)], 1u);
    return b;
}
__device__ __forceinline__ void xcd_barrier_complete(unsigned* bar, unsigned x, unsigned& nloc, unsigned& nx) {
    const unsigned G = gridDim.x * gridDim.y * gridDim.z;
    unsigned sum, cnt, mine, sp = 0u;
    for (;;) {
        sum = 0u; cnt = 0u; mine = 0u;
#pragma unroll
        for (unsigned j = 0; j < 16; ++j) { const unsigned c = xb_ld(&bar[XB_XCNT(j)]); sum += c; cnt += (c > 0u) ? 1u : 0u; mine = (j == x) ? c : mine; }
        if (sum == G) break;
        __builtin_amdgcn_s_sleep(1);
        if ((++sp & 255u) == 0u) { if (xb_ld(&bar[XB_TMO])) break; if (sp > XB_SPIN_CAP) { atomicAdd(&bar[XB_TMO], 1u); break; } }
    }
    nloc = mine > 0u ? mine : 1u; nx = cnt > 0u ? cnt : 1u;
}
__device__ __forceinline__ void xcd_barrier(const XcdBarrier& b) {
    asm volatile("s_waitcnt vmcnt(0)" ::: "memory");
    __syncthreads();
    if (threadIdx.x == 0) {
        unsigned* bar = b.bar;
        __builtin_amdgcn_s_waitcnt(0);
        unsigned nloc = b.st[0], nx = b.st[1];
        if (nloc == 0u) { xcd_barrier_complete(bar, b.x, nloc, nx); b.st[0] = nloc; b.st[1] = nx; }
        const unsigned old = xb_add(&bar[XB_XSUB(b.x)], 1u);
        const unsigned gen = old / nloc;
        if (old + 1u == (gen + 1u) * nloc) {
            __builtin_amdgcn_fence(__ATOMIC_RELEASE, "agent");
            asm volatile("s_waitcnt vmcnt(0)" ::: "memory");
            const unsigned og = xb_add(&bar[XB_TOP], 1u);
            const unsigned tg = og / nx;
            if (og + 1u == (tg + 1u) * nx) xb_add(&bar[XB_TOPGEN], 1u);
            else XB_SPIN(xb_ld(&bar[XB_TOPGEN]) == tg, bar);
            __builtin_amdgcn_fence(__ATOMIC_ACQUIRE, "agent");
            xb_add(&bar[XB_XGEN(b.x)], 1u);
            asm volatile("s_waitcnt vmcnt(0)" ::: "memory");
        } else {
            XB_SPIN(xb_ld(&bar[XB_XGEN(b.x)]) == gen, bar);
            __builtin_amdgcn_fence(__ATOMIC_ACQUIRE, "agent");
            asm volatile("s_waitcnt vmcnt(0)" ::: "memory");
        }
    }
    __syncthreads();
}

struct Args { const float* in[14]; float* out; unsigned char* ws; int ph_lo, ph_hi, li, pad; };
constexpr int N_PHASES = 2 + 5 * DEPTH;

__device__ __forceinline__ void transpose_item(const float* W, const float* gain, int K, int N, bf16_t* WT, LAS float* scr, int item, int lane) {
    const int nblk = N / 32, kb = item / nblk, nb = item % nblk, k0 = 64 * kb, n0 = 32 * nb;
#pragma unroll 8
    for (int i = 0; i < 32; ++i) { const int kk = 2 * i + (lane >> 5); const float gk = gain ? gain[k0 + kk] : 1.0f; scr[kk * 33 + (lane & 31)] = W[(size_t)(k0 + kk) * N + n0 + (lane & 31)] * gk; }
    LDS_WAIT(); asm volatile("" ::: "memory");
    const int c = lane & 7;
#pragma unroll
    for (int j = 0; j < 4; ++j) { const int n = (lane >> 3) + 8 * j; const LAS float* s = scr + (8 * c) * 33 + n;
        u32x4 o; o.x = cvtpk(s[0 * 33], s[1 * 33]); o.y = cvtpk(s[2 * 33], s[3 * 33]); o.z = cvtpk(s[4 * 33], s[5 * 33]); o.w = cvtpk(s[6 * 33], s[7 * 33]);
        *(u32x4*)(WT + (size_t)(n0 + n) * K + k0 + 8 * c) = o; }
    LDS_WAIT(); asm volatile("" ::: "memory");
}

__global__ void __launch_bounds__(NWAVES * 64, 2) fwd_kernel(Args args) {
    extern __shared__ __attribute__((aligned(16))) unsigned char lds_raw[];
    LAS unsigned char* lds = (LAS unsigned char*)lds_raw;
    volatile LAS unsigned* MISC = (volatile LAS unsigned*)(lds + MISC_OFF);
    const int G = gridDim.x; const int bx = blockIdx.x; const int vcu = (G % 8 == 0) ? (bx % 8) * (G / 8) + bx / 8 : bx;
    unsigned char* ws = args.ws;
    unsigned* ctl = (unsigned*)(ws + WS_CTL);
    const float* x_p = args.in[0]; const float* x_s = args.in[1];
    const float* norm_mix = args.in[2]; const float* w_in = args.in[3]; const float* rpb = args.in[4]; const float* sinks = args.in[5];
    const float* norm_grp = args.in[6]; const float* w_out = args.in[7]; const float* norm_ffn = args.in[8]; const float* w_up = args.in[9];
    const float* conv_w = args.in[10]; const float* conv_b = args.in[11]; const float* w_down = args.in[12]; const float* norm_final = args.in[13];
    float* out = args.out;
    bf16_t* XB = (bf16_t*)(ws + WS_XB); float* SSX = (float*)(ws + WS_SSX); float* SSA = (float*)(ws + WS_SSA);
    bf16_t* PROJ = (bf16_t*)(ws + WS_PROJ); bf16_t* ATT = (bf16_t*)(ws + WS_ATT); bf16_t* HID = (bf16_t*)(ws + WS_HID);

    for (int u = threadIdx.x; u < 256; u += NWAVES * 64) ((LAS unsigned*)(lds + MISC_OFF))[u] = 0u;
    __syncthreads();
    XcdBarrier bar; bar.bar = ctl + CW_BAR; bar.x = 0; bar.st = nullptr;
    if (MK_N_LAUNCHES == 1) bar = xcd_barrier_post(ctl + CW_BAR, MISC + 8);
    const int lo = args.ph_lo, hi_ph = args.ph_hi;
#define PHASE_IDS int tid_ = threadIdx.x; asm volatile("" : "+v"(tid_)); const int tid = tid_, lane = tid & 63, wave = __builtin_amdgcn_readfirstlane(tid >> 6); const int gw = vcu * NWAVES + wave, NGW = G * NWAVES; (void)lane; (void)gw; (void)NGW
#ifndef PH_MASK
#define PH_MASK 0x7f
#endif
#define KIND(k) ((k) == 0 ? 0 : ((k) == N_PHASES - 1 ? 6 : 1 + ((k) - 1) % 5))
#define IN(k) (((PH_MASK >> KIND(k)) & 1) && lo <= (k) && (k) < hi_ph)
#define SEAM(k) do { if (IN(k) && IN((k) + 1)) xcd_barrier(bar); } while (0)

    for (int rep = 0; rep <= ((REP_MASK >> 0) & 1); ++rep) if (IN(0)) {
        PHASE_IDS;
        LAS float* scr = (LAS float*)(lds + wave * 16384);
        constexpr int I_IN = (D / 64) * (NIN / 32), I_OUT = (D / 64) * (D / 32), I_UP = (D / 64) * (NUP / 32), I_DN = (DFF / 64) * (D / 32), I_L = I_IN + I_OUT + I_UP + I_DN;
        for (int it = gw; it < DEPTH * I_L; it += NGW) {
            const int l = it / I_L; int r = it % I_L;
            unsigned char* wl = ws + WS_W + (size_t)l * W_LAYER_B;
            if (r < I_IN) { transpose_item(w_in + (size_t)l * D * NIN, norm_mix + l * D, D, NIN, (bf16_t*)wl, scr, r, lane); continue; } r -= I_IN;
            if (r < I_OUT) { transpose_item(w_out + (size_t)l * D * D, norm_grp + l * D, D, D, (bf16_t*)(wl + W_IN_B), scr, r, lane); continue; } r -= I_OUT;
            if (r < I_UP) { transpose_item(w_up + (size_t)l * D * NUP, norm_ffn + l * D, D, NUP, (bf16_t*)(wl + W_IN_B + W_OUT_B), scr, r, lane); continue; } r -= I_UP;
            transpose_item(w_down + (size_t)l * DFF * D, nullptr, DFF, D, (bf16_t*)(wl + W_IN_B + W_OUT_B + W_UP_B), scr, r, lane);
        }
        for (int m0 = 4 * gw; m0 < M; m0 += 4 * NGW) {
            f32x4 v[4][4];
#pragma unroll
            for (int r = 0; r < 4; ++r) { const int m = m0 + r; const GAS float* xr = (m < SEQ) ? (const GAS float*)x_p + (size_t)m * D : (const GAS float*)x_s + (size_t)(m - SEQ) * D;
#pragma unroll
                for (int j = 0; j < 4; ++j) v[r][j] = *(const GAS f32x4*)(xr + 4 * lane + 256 * j); }
#pragma unroll
            for (int r = 0; r < 4; ++r) { const int m = m0 + r; float s = 0.f;
#pragma unroll
                for (int j = 0; j < 4; ++j) s += (v[r][j][0] * v[r][j][0] + v[r][j][1] * v[r][j][1]) + (v[r][j][2] * v[r][j][2] + v[r][j][3] * v[r][j][3]);
                s = wave_sum(s);
#pragma unroll
                for (int j = 0; j < 4; ++j) { u32x2 w; w.x = cvtpk(v[r][j][0], v[r][j][1]); w.y = cvtpk(v[r][j][2], v[r][j][3]); *(GAS u32x2*)((GAS bf16_t*)XB + (size_t)(m + m / SEQ) * D + 4 * lane + 256 * j) = w; }
                if (lane < 16) ((GAS float*)SSX)[(size_t)m * 16 + lane] = s * (1.0f / 16.0f); }
        }
        for (int z = gw; z < 3 + 300; z += NGW) {
            const long prow = (z == 0) ? -1 : (z == 1) ? SEQ : (z == 2) ? 2 * SEQ + 1 : (long)MP + (z - 3);
#pragma unroll
            for (int j = 0; j < 4; ++j) *(u32x2*)(XB + prow * D + 4 * lane + 256 * j) = (u32x2){0u, 0u};
        }
    }
    SEAM(0);

    for (int l = 0; l < DEPTH; ++l) {
        const int pb = 1 + 5 * l;
        const unsigned char* wl = ws + WS_W + (size_t)l * W_LAYER_B;
        const char* Win_t = (const char*)wl; const char* Wout_t = (const char*)(wl + W_IN_B); const char* Wup_t = (const char*)(wl + W_IN_B + W_OUT_B); const char* Wdn_t = (const char*)(wl + W_IN_B + W_OUT_B + W_UP_B);

        for (int rep = 0; rep <= ((REP_MASK >> 1) & 1); ++rep) if (IN(pb)) {
            PHASE_IDS;
            pg8::StaticOrder S; S.init(M / 256, NIN / 256, G, bx);
            LAS float* tab = (LAS float*)(lds + TAB_OFF);
            { pg8::Unit u; for (int i = tid >> 8; S.next(i, u); i += 2) { const int row = tid & 255; const float* p = SSX + (size_t)(u.pm * 256 + row) * 16;
                const f32x4 a = *(const f32x4*)p, b = *(const f32x4*)(p + 4), c = *(const f32x4*)(p + 8), d = *(const f32x4*)(p + 12);
                const float s = ((a[0] + a[1]) + (a[2] + a[3])) + ((b[0] + b[1]) + (b[2] + b[3])) + ((c[0] + c[1]) + (c[2] + c[3])) + ((d[0] + d[1]) + (d[2] + d[3]));
                tab[i * 256 + row] = 1.0f / sqrtf(s * (1.0f / D) + EPS); } }
            __syncthreads();
            pg8::Gemm g{(const char*)XB, Win_t, D, 256L * D * 2, 128L * D * 2, 256L * D * 2, 128L * D * 2, 0, (long)D * 2};
            pg8::EpiProj E{PROJ, tab};
            pg8::gemm_phase<pg8::EpiProj, true>(lds, g, S, E);
        }
        SEAM(pb);

        for (int rep = 0; rep <= ((REP_MASK >> 2) & 1); ++rep) if (IN(pb + 1)) {
            PHASE_IDS;
            LAS float* tab = (LAS float*)(lds + TAB_OFF);
            for (int i = tid; i < 8 * 15 * 32; i += NWAVES * 64) { const int h = i / 480, rem = i % 480, dr = rem >> 5, o = rem & 31;
                tab[i] = (o < 31) ? rpb[((size_t)(l * 8 + h) * 15 + dr) * 31 + o] * LOG2E : 0.f; }
            __syncthreads();
            for (int rp = 0; rp <= ((REP_MASK >> 8) & 1); ++rp)
            for (int n = vcu; n < 1536; n += G) {
                const int r4 = n & 63, h = (n >> 6) & 7, sq = n >> 9; const int r0 = 4 * r4, r = r0 + (wave >> 1);
                const int rs0 = min(max(r0 - 4, 0), 248), rs3 = min(max(r0 - 1, 0), 248), rs = min(max(r - 4, 0), 248);
                att::block_unit<0>(lds, PROJ, ATT, SSA, lane, wave, sq * SEQ + rs0 * 64, rs3 + 8 - rs0, COL_KA + h * 64, COL_VA + h * 64, rs - rs0, 8,
                                   sq * SEQ + r * 64 + 32 * (wave & 1), wave & 1, COL_QA + h * 64, tab + h * 480, rs - r + 7, 0.f, 0.f, h * 64, h);
            }
            for (int rp = 0; rp <= ((REP_MASK >> 9) & 1); ++rp)
            for (int n = vcu; n < 1536; n += G) {
                const int tt = n & 255, kvh = (n >> 8) & 1, sq = n >> 9; const int hb = 4 * kvh + (wave >> 1), t0 = 64 * tt;
                const int u_lo = max(t0 - 128, 0), u_hi = min(t0 + 192, SEQ);
                const float slope2 = __builtin_amdgcn_exp2f(-(float)(hb + 1)) * LOG2E; const float sink2 = sinks[l * 8 + hb] * LOG2E;
                att::block_unit<1>(lds, PROJ, ATT, SSA, lane, wave, sq * SEQ + u_lo, (u_hi - u_lo) >> 6, COL_KB + kvh * 64, COL_VB + kvh * 64, 0, (u_hi - u_lo) >> 6,
                                   sq * SEQ + t0 + 32 * (wave & 1), wave & 1, COL_QB + hb * 64, nullptr, 0, slope2, sink2, 512 + hb * 64, 8 + hb);
            }
            __syncthreads();
        }
        SEAM(pb + 1);

        if (IN(pb + 2)) {
            PHASE_IDS;
            pg8::StaticOrder S; S.init(M / 256, D / 256, G, bx);
            LAS f32x2* tab = (LAS f32x2*)(lds + TAB_OFF);
            { pg8::Unit u; for (int i = tid >> 8; S.next(i, u); i += 2) { const int row = tid & 255; const float* p = SSA + (size_t)(u.pm * 256 + row) * 16;
                const f32x4 a = *(const f32x4*)p, b = *(const f32x4*)(p + 4), c = *(const f32x4*)(p + 8), d = *(const f32x4*)(p + 12);
                const float sa = ((a[0] + a[1]) + (a[2] + a[3])) + ((b[0] + b[1]) + (b[2] + b[3])), sb = ((c[0] + c[1]) + (c[2] + c[3])) + ((d[0] + d[1]) + (d[2] + d[3]));
                const float ia = 1.0f / sqrtf(sa * (1.0f / 512.f) + EPS), ib = 1.0f / sqrtf(sb * (1.0f / 512.f) + EPS);
                tab[i * 256 + row] = (f32x2){ia / ib, ib}; } }
            __syncthreads();
            pg8::Gemm g{(const char*)ATT, Wout_t, D, 256L * D * 2, 128L * D * 2, 256L * D * 2, 128L * D * 2, 0, 0L};
            pg8::EpiRes<true> E{XB, SSX, tab};
            pg8::gemm_phase<pg8::EpiRes<true>, true>(lds, g, S, E);
        }
        SEAM(pb + 2);

        for (int rep = 0; rep <= ((REP_MASK >> 4) & 1); ++rep) if (IN(pb + 3)) {
            PHASE_IDS;
            pg8::StaticOrder S; S.init(UP_NM, DFF / 128, G, bx, UP_WGM);
            LAS float* tab = (LAS float*)(lds + TAB_OFF);
            { pg8::Unit u; for (int i = tid >> 8; S.next(i, u); i += 2) { const int row = tid & 255; const int ai = row >> 7, wr = (row >> 6) & 1, m = (row >> 4) & 3, fr = row & 15;
                const int pp = UPM * u.pm - 1 + 126 * wr + 8 * fr + 4 * ai + m; float v = 0.f;
                const int tok = pp - (pp > SEQ ? 1 : 0) - (pp > 2 * SEQ + 1 ? 1 : 0);
                if (pp >= 0 && pp < MP && pp != SEQ && pp != 2 * SEQ + 1) { const float* p = SSX + (size_t)tok * 16;
                    const f32x4 a = *(const f32x4*)p, b = *(const f32x4*)(p + 4), c = *(const f32x4*)(p + 8), d = *(const f32x4*)(p + 12);
                    const float s = ((a[0] + a[1]) + (a[2] + a[3])) + ((b[0] + b[1]) + (b[2] + b[3])) + ((c[0] + c[1]) + (c[2] + c[3])) + ((d[0] + d[1]) + (d[2] + d[3]));
                    v = 1.0f / sqrtf(s * (1.0f / D) + EPS); }
                tab[i * 256 + row] = v; } }
            __syncthreads();
            pg8::Gemm g{(const char*)(XB - D), Wup_t, D, (long)UPM * D * 2, 4L * D * 2, 128L * D * 2, (long)DFF * D * 2, 1, 0L};
            pg8::EpiUp E{HID, conv_w + (size_t)l * 3 * NUP, conv_b + (size_t)l * NUP, tab, lds + TAB_OFF + 18 * 1024};
            pg8::gemm_phase<pg8::EpiUp, true>(lds, g, S, E);
        }
        SEAM(pb + 3);

        if (IN(pb + 4)) {
            PHASE_IDS;
            pg8::StaticOrder S; S.init(M / 256, D / 256, G, bx, pg8::WGM, 1);
            pg8::Gemm g{(const char*)HID, Wdn_t, DFF, 256L * DFF * 2, 128L * DFF * 2, 256L * DFF * 2, 128L * DFF * 2, 0, 0L};
            if (l == DEPTH - 1 && FUSE_FINAL) {
                pg8::EpiFin E{XB, out, norm_final, (float*)(ws + WS_XSLOT), ctl + CW_CNT, lds + TAB_OFF};
                pg8::gemm_phase<pg8::EpiFin, true>(lds, g, S, E);
            } else {
                pg8::EpiRes<false> E{XB, SSX, nullptr};
                pg8::gemm_phase<pg8::EpiRes<false>, true>(lds, g, S, E);
            }
        }
        if (!(FUSE_FINAL && l == DEPTH - 1)) SEAM(pb + 4);
    }

    if (!FUSE_FINAL) for (int rep = 0; rep <= ((REP_MASK >> 6) & 1); ++rep) if (IN(N_PHASES - 1)) {
        PHASE_IDS;
        for (int m0 = 4 * gw; m0 < M; m0 += 4 * NGW) {
            u32x4 rw[4][2]; float sv[4];
#pragma unroll
            for (int r = 0; r < 4; ++r) { const int m = m0 + r; const GAS bf16_t* xr = (const GAS bf16_t*)XB + (size_t)(m + m / SEQ) * D;
                sv[r] = ((const GAS float*)SSX)[(size_t)m * 16 + (lane & 15)];
#pragma unroll
                for (int j = 0; j < 2; ++j) rw[r][j] = *(const GAS u32x4*)(xr + 8 * lane + 512 * j); }
            f32x4 g0[2], g1[2];
#pragma unroll
            for (int j = 0; j < 2; ++j) { g0[j] = *(const GAS f32x4*)((const GAS float*)norm_final + 8 * lane + 512 * j); g1[j] = *(const GAS f32x4*)((const GAS float*)norm_final + 8 * lane + 512 * j + 4); }
#pragma unroll
            for (int r = 0; r < 4; ++r) { const int m = m0 + r; float s = sv[r];
                s += __shfl_xor(s, 1); s += __shfl_xor(s, 2); s += __shfl_xor(s, 4); s += __shfl_xor(s, 8);
                const float inv = 1.0f / sqrtf(s * (1.0f / D) + EPS);
                GAS float* orow = (GAS float*)out + (size_t)m * D;
#pragma unroll
                for (int j = 0; j < 2; ++j) { const u32x4 w = rw[r][j];
                    const f32x4 v0 = (f32x4){pg8::bf_lo(w.x), pg8::bf_hi(w.x), pg8::bf_lo(w.y), pg8::bf_hi(w.y)}, v1 = (f32x4){pg8::bf_lo(w.z), pg8::bf_hi(w.z), pg8::bf_lo(w.w), pg8::bf_hi(w.w)};
                    *(GAS f32x4*)(orow + 8 * lane + 512 * j) = v0 * inv * g0[j]; *(GAS f32x4*)(orow + 8 * lane + 512 * j + 4) = v1 * inv * g1[j]; } }
        }
    }
#undef IN
#undef SEAM
}

extern "C" void kernel_launch(void* const* d_in, const int* in_sizes, int n_in, void* d_out, int out_size, void* d_ws, size_t ws_size, hipStream_t stream) {
    static int grid = 0;
    if (grid == 0) {
        if (n_in != 14 || in_sizes[0] != SEQ * D || in_sizes[1] != 2 * SEQ * D || out_size != M * D || ws_size < WS_END) {
            fprintf(stderr, "kernel_launch: unexpected shapes (n_in %d, in0 %d, in1 %d, out %d, ws %zu; need ws >= %zu); nothing launched\n", n_in, n_in > 0 ? in_sizes[0] : -1, n_in > 1 ? in_sizes[1] : -1, out_size, ws_size, (size_t)WS_END);
            grid = -1; return; }
        int dev = 0, cus = 0;
        if (hipGetDevice(&dev) != hipSuccess || hipDeviceGetAttribute(&cus, hipDeviceAttributeMultiprocessorCount, dev) != hipSuccess) { fprintf(stderr, "kernel_launch: device query failed\n"); grid = -1; return; }
        if (hipFuncSetAttribute((const void*)fwd_kernel, hipFuncAttributeMaxDynamicSharedMemorySize, LDS_BYTES) != hipSuccess) { fprintf(stderr, "kernel_launch: hipFuncSetAttribute failed\n"); grid = -1; return; }
        int per_cu = 0;
        if (hipOccupancyMaxActiveBlocksPerMultiprocessor(&per_cu, (const void*)fwd_kernel, NWAVES * 64, LDS_BYTES) != hipSuccess || per_cu < 1)
            fprintf(stderr, "kernel_launch: note: occupancy query reports %d workgroups per CU\n", per_cu);
        (void)hipGetLastError();
        grid = cus;
    }
    if (grid < 0) return;
    if (hipMemsetAsync((char*)d_ws + WS_CTL, 0, CTL_ZERO_BYTES, stream) != hipSuccess) { fprintf(stderr, "kernel_launch: memset failed\n"); return; }
    Args a{};
    for (int i = 0; i < 14; ++i) a.in[i] = (const float*)d_in[i];
    a.out = (float*)d_out; a.ws = (unsigned char*)d_ws;
    if (MK_N_LAUNCHES == 1) {
        a.ph_lo = 0; a.ph_hi = N_PHASES; a.li = 0;
        hipLaunchKernelGGL(fwd_kernel, dim3(grid), dim3(NWAVES * 64), LDS_BYTES, stream, a);
    } else {
        for (int p = 0; p < N_PHASES; ++p) { a.ph_lo = p; a.ph_hi = p + 1; a.li = p; hipLaunchKernelGGL(fwd_kernel, dim3(grid), dim3(NWAVES * 64), LDS_BYTES, stream, a); }
    }
    const hipError_t le = hipPeekAtLastError();
    if (le != hipSuccess) fprintf(stderr, "kernel_launch: launch failed: %s\n", hipGetErrorName(le));
}
```

```cpp
#include <hip/hip_runtime.h>
#include <cstdio>
#include <cstdint>

#ifndef MK_N_LAUNCHES
#define MK_N_LAUNCHES 1
#endif

#ifndef REP_MASK
#define REP_MASK 0
#endif
#define LAS __attribute__((address_space(3)))
#define GAS __attribute__((address_space(1)))
typedef unsigned short bf16_t;
typedef short bf16x8 __attribute__((ext_vector_type(8)));
typedef short s16x4 __attribute__((ext_vector_type(4)));
typedef float f32x2 __attribute__((ext_vector_type(2)));
typedef float f32x4 __attribute__((ext_vector_type(4)));
typedef float f32x16 __attribute__((ext_vector_type(16)));
typedef unsigned u32x2 __attribute__((ext_vector_type(2)));
typedef unsigned u32x4 __attribute__((ext_vector_type(4)));
typedef __bf16 bf16x2_t __attribute__((ext_vector_type(2)));

constexpr int SEQ = 16384, NSEQ = 3, M = NSEQ * SEQ;
constexpr int D = 1024, NIN = 2304, DFF = 2816, NUP = 2 * DFF, DEPTH = 2;
constexpr int COL_QA = 0, COL_KA = 512, COL_VA = 1024, COL_QB = 1536, COL_KB = 2048, COL_VB = 2176;
constexpr float EPS = 1e-6f;
constexpr float LOG2E = 1.4426950408889634f;
constexpr float C2 = 0.125f * LOG2E;
#ifndef UP_WGM
#define UP_WGM 8
#endif
constexpr int UPM = 252;
constexpr int MP = M + NSEQ - 1;
constexpr int UP_NM = (MP + UPM - 1) / UPM;

constexpr size_t MiB = 1u << 20;
constexpr size_t WS_CTL = 0, CTL_ZERO_BYTES = 128 * 1024;
constexpr size_t W_IN_B = (size_t)NIN * D * 2, W_OUT_B = (size_t)D * D * 2, W_UP_B = (size_t)NUP * D * 2, W_DN_B = (size_t)D * DFF * 2;
constexpr size_t WS_W = 1 * MiB, W_LAYER_B = W_IN_B + W_OUT_B + W_UP_B + W_DN_B;
constexpr size_t WS_XB = 48 * MiB + 4096;
constexpr size_t WS_SSX = 146 * MiB, WS_SSA = 149 * MiB;
constexpr size_t WS_PROJ = 152 * MiB;
constexpr size_t WS_ATT = 368 * MiB;
constexpr size_t WS_HID = 152 * MiB;
constexpr size_t WS_END = 464 * MiB;
static_assert(WS_W + DEPTH * W_LAYER_B <= 48 * MiB && WS_XB + (size_t)(MP + 300) * D * 2 <= WS_SSX && WS_SSX + (size_t)M * 64 <= WS_SSA && WS_SSA + (size_t)M * 64 <= WS_PROJ, "ws map");
static_assert(WS_PROJ + (size_t)M * NIN * 2 <= WS_ATT && WS_ATT + (size_t)M * D * 2 <= WS_END && WS_HID + (size_t)M * DFF * 2 <= WS_END, "ws map");
constexpr int CW_BAR = 1024;
constexpr int CW_CNT = 4608;
constexpr size_t WS_CONV = 47 * MiB + 800 * 1024;
constexpr size_t WS_XSLOT = 47 * MiB;
#ifndef FUSE_FINAL
#define FUSE_FINAL 1
#endif

constexpr int RING_BYTES = 131072;
constexpr int MISC_OFF = RING_BYTES;
constexpr int TAB_OFF = RING_BYTES + 1024;
constexpr int TAB_BYTES = 26 * 1024;
constexpr int LDS_BYTES = TAB_OFF + TAB_BYTES;
constexpr int NWAVES = 8;

__device__ __forceinline__ unsigned cvtpk(float lo, float hi) { f32x2 v = {lo, hi}; bf16x2_t b = __builtin_convertvector(v, bf16x2_t); return __builtin_bit_cast(unsigned, b); }
__device__ __forceinline__ float wave_sum(float v) {
#pragma unroll
    for (int o = 1; o < 64; o <<= 1) v += __shfl_xor(v, o);
    return v;
}
__device__ __forceinline__ float dpp_shr1(float x) { return __int_as_float(__builtin_amdgcn_update_dpp(0, __float_as_int(x), 0x111, 0xf, 0xf, true)); }
__device__ __forceinline__ float dpp_shl1(float x) { return __int_as_float(__builtin_amdgcn_update_dpp(0, __float_as_int(x), 0x101, 0xf, 0xf, true)); }
__device__ __forceinline__ float swap_max(float v) { auto rr = __builtin_amdgcn_permlane32_swap(__float_as_uint(v), __float_as_uint(v), false, false); return fmaxf(__uint_as_float(rr[0]), __uint_as_float(rr[1])); }
__device__ __forceinline__ float swap_sum(float v) { auto rr = __builtin_amdgcn_permlane32_swap(__float_as_uint(v), __float_as_uint(v), false, false); return __uint_as_float(rr[0]) + __uint_as_float(rr[1]); }
__device__ __forceinline__ float sum_x16_x32(float v) {
    auto a = __builtin_amdgcn_permlane16_swap(__float_as_uint(v), __float_as_uint(v), false, false); v = __uint_as_float(a[0]) + __uint_as_float(a[1]);
    auto b = __builtin_amdgcn_permlane32_swap(__float_as_uint(v), __float_as_uint(v), false, false); return __uint_as_float(b[0]) + __uint_as_float(b[1]); }
#define LDS_WAIT() asm volatile("s_waitcnt lgkmcnt(0)" ::: "memory")
__device__ __forceinline__ void glds16(const void* gsrc, unsigned lds_dst) { unsigned keep;
    asm volatile("s_mov_b32 %0, m0\n\ts_mov_b32 m0, %2\n\ts_nop 0\n\tglobal_load_lds_dwordx4 %1, off\n\ts_mov_b32 m0, %0" : "=&s"(keep) : "v"(gsrc), "s"(lds_dst) : "memory"); }
__device__ __forceinline__ void glds16s(unsigned voff, const void* sbase, unsigned lds_dst) { unsigned keep;
    asm volatile("s_mov_b32 %0, m0\n\ts_mov_b32 m0, %3\n\ts_nop 0\n\tglobal_load_lds_dwordx4 %1, %2\n\ts_mov_b32 m0, %0" : "=&s"(keep) : "v"(voff), "s"(sbase), "s"(lds_dst) : "memory"); }
__device__ __forceinline__ int lane_now() { int l; asm volatile("v_mbcnt_lo_u32_b32 %0, -1, 0\n\tv_mbcnt_hi_u32_b32 %0, -1, %0" : "=v"(l)); return l; }
__device__ __forceinline__ void glds16s2(unsigned voff0, unsigned voff1, const void* sbase, unsigned lds_dst) {
    asm volatile("s_mov_b32 m0, %3\n\ts_nop 0\n\tglobal_load_lds_dwordx4 %0, %2\n\ts_add_u32 m0, m0, 0x2000\n\ts_nop 0\n\tglobal_load_lds_dwordx4 %1, %2"
                 :: "v"(voff0), "v"(voff1), "s"(sbase), "s"(lds_dst) : "m0", "scc", "memory"); }
__device__ __forceinline__ void glds16kv(unsigned voffk, unsigned voffv, const void* sk, const void* sv, unsigned lds_dst) {
    asm volatile("s_mov_b32 m0, %4\n\ts_nop 0\n\tglobal_load_lds_dwordx4 %0, %2\n\ts_add_u32 m0, m0, 0x2000\n\ts_nop 0\n\tglobal_load_lds_dwordx4 %1, %3"
                 :: "v"(voffk), "v"(voffv), "s"(sk), "s"(sv), "s"(lds_dst) : "m0", "scc", "memory"); }
#define VM_WAIT() asm volatile("s_waitcnt vmcnt(0)" ::: "memory")

namespace pg8 {
constexpr int BM = 256, BK = 64, HALF = 128, HTB = HALF * BK * 2, NXCD = 8, WGM = 8;
__host__ __device__ __forceinline__ int lds_byte(int r, int c) { const int st = (r >> 4) * 2 + (c >> 5), rr = r & 15, cc = c & 31, ob = rr * 64 + cc * 2; return st * 1024 + (ob ^ (((ob >> 9) & 1) << 5)); }
__host__ __device__ __forceinline__ void stage_rc(int b, int& R, int& C) { const int st = b / 1024, sb = b % 1024, swz = sb ^ (((sb >> 9) & 1) << 5); R = (st >> 1) * 16 + swz / 64; C = (st & 1) * 32 + (swz % 64) / 2; }
__host__ __device__ __forceinline__ int perm32(int rho) { const int n = rho >> 4, i = rho & 15; return 8 * (i >> 2) + 4 * n + (i & 3); }

struct Unit { int pm, pn; };
struct Gemm { const char* A; const char* Bt; int K; long a_tstep, a_hstep, b_tstep, b_hstep; int amap; long a_pad; };

struct StaticOrder {
    int nM, nN, nwg, G, c, wgm, rev;
    __device__ void init(int nM_, int nN_, int G_, int c_, int wgm_ = WGM, int rev_ = 0) { nM = nM_; nN = nN_; nwg = nM * nN; G = G_; c = c_; wgm = wgm_; rev = rev_; }
    __device__ bool next(int i, Unit& u) const {
        const long L = (long)i * G + c; if (L >= nwg) return false;
        int wgid = (int)L; { const int q = nwg / NXCD, r = nwg % NXCD, xcd = wgid % NXCD, off = wgid / NXCD; wgid = (xcd < r ? xcd * (q + 1) : r * (q + 1) + (xcd - r) * q) + off; }
        const int nig = wgm * nN, gid = wgid / nig, fm = gid * wgm, gsz = (nM - fm) < wgm ? (nM - fm) : wgm;
        u.pm = fm + ((wgid % nig) % gsz); u.pn = (wgid % nig) / gsz; if (rev) u.pm = nM - 1 - u.pm; return true;
    }
};

struct NoPre { __device__ __forceinline__ void operator()() const {} };
template <class Epi, bool ALIGN_EPI, bool EARLY_DRAIN = true, class Pre = NoPre>
__device__ __forceinline__ void gemm_phase(LAS unsigned char* lds, const Gemm g, const StaticOrder& S, const Epi& E, int wv, const Pre& pre = Pre()) {
    int tid_ = wv * 64 + lane_now(); asm volatile("" : "+v"(tid_));
    const int tid = tid_, wid = __builtin_amdgcn_readfirstlane(tid >> 6), lane = tid & 63, wr = wid >> 2, wc = wid & 3, fr = lane & 15, fq = lane >> 4;
    const int K = g.K, nt = K / BK;
    unsigned voffA[2], voffB[2];
#pragma unroll
    for (int i = 0; i < 2; ++i) { int R, C; stage_rc(tid * 16 + i * 8192, R, C); const int Rb = (R & ~31) + perm32(R & 31);
        const int Ra = g.amap ? (126 * (R >> 6) + 8 * (R & 15) + ((R >> 4) & 3)) : R;
        voffA[i] = (unsigned)(Ra * K + C) * 2u; voffB[i] = (unsigned)(Rb * K + C) * 2u; }
    const size_t kstep = (size_t)(BK * 2);
    const size_t ahs = (size_t)g.a_hstep, bhs = (size_t)g.b_hstep;
    const unsigned ldsw = (unsigned)wid * 1024u; const unsigned ldsn = (unsigned)(uintptr_t)lds + ldsw;
    const int aoff = lds_byte(wr * 64 + fr, fq * 8), boff = lds_byte(wc * 32 + fr, fq * 8);
#define PG8_SA(b, h) (((b) * 2 + (h)) * HTB)
#define PG8_SB(b, h) ((4 + (b) * 2 + (h)) * HTB)
#define PG8_STAGE(bufoff, gbase, voff) glds16s2((voff)[0], (voff)[1], (const void*)(gbase), ldsn + (unsigned)(bufoff))
#define PG8_LDA(dst, b, h) do { _Pragma("unroll") for (int m = 0; m < 4; ++m) _Pragma("unroll") for (int k = 0; k < 2; ++k) dst[m][k] = *(const LAS bf16x8*)(lds + PG8_SA(b, h) + aoff + m * 2048 + k * 1024); } while (0)
#define PG8_LDB(dst, b, h) do { _Pragma("unroll") for (int n = 0; n < 2; ++n) _Pragma("unroll") for (int k = 0; k < 2; ++k) dst[n][k] = *(const LAS bf16x8*)(lds + PG8_SB(b, h) + boff + n * 2048 + k * 1024); } while (0)
#define PG8_MMA(ai, bj, At, Bt) do { __builtin_amdgcn_s_setprio(1); _Pragma("unroll") for (int m = 0; m < 4; ++m) _Pragma("unroll") for (int n = 0; n < 2; ++n) _Pragma("unroll") for (int k = 0; k < 2; ++k) \
        acc[ai][bj][m][n] = __builtin_amdgcn_mfma_f32_16x16x32_bf16(Bt[n][k], At[m][k], acc[ai][bj][m][n], 0, 0, 0); __builtin_amdgcn_s_setprio(0); } while (0)
#define PG8_WAIT_V(n) asm volatile("s_waitcnt vmcnt(" #n ")" ::: "memory")
#define PG8_WAIT_V8_UNLESS(f) asm volatile("s_cmp_lg_u32 %0, 0\n\ts_cbranch_scc1 .Lpg8w%=\n\ts_waitcnt vmcnt(8)\n.Lpg8w%=:" :: "s"(f) : "scc", "memory")
#define PG8_WAIT_L(n) asm volatile("s_waitcnt lgkmcnt(" #n ")" ::: "memory")
#define PG8_BAR __builtin_amdgcn_s_barrier()
#define PG8_SCHED __builtin_amdgcn_sched_barrier(0)
    Unit cur, nxt; int ui = 0; bool fresh = false;
    if (!S.next(0, cur)) return;
    f32x4 acc[2][2][4][2];
#pragma unroll
    for (int a = 0; a < 2; ++a)
#pragma unroll
        for (int b = 0; b < 2; ++b)
#pragma unroll
            for (int m = 0; m < 4; ++m)
#pragma unroll
                for (int n = 0; n < 2; ++n) acc[a][b][m][n] = (f32x4){0.f, 0.f, 0.f, 0.f};
    bf16x8 At[4][2], B0[2][2], B1[2][2];
    const char* cA = g.A + (size_t)cur.pm * g.a_tstep + (size_t)(cur.pm >> 6) * g.a_pad; const char* cB = g.Bt + (size_t)cur.pn * g.b_tstep;
    if constexpr (Epi::HOOK) E.unit_start(cur, ui, wid, lane);
    PG8_STAGE(PG8_SB(0, 0), cB, voffB); PG8_STAGE(PG8_SB(0, 1), cB + bhs, voffB); PG8_STAGE(PG8_SA(0, 0), cA, voffA); PG8_STAGE(PG8_SA(0, 1), cA + ahs, voffA);
    pre();
    if (wr == 1) PG8_BAR;
    PG8_WAIT_V(2); PG8_BAR;
    PG8_STAGE(PG8_SB(1, 0), cB + kstep, voffB); PG8_STAGE(PG8_SA(1, 0), cA + kstep, voffA); PG8_STAGE(PG8_SB(1, 1), cB + bhs + kstep, voffB);
    PG8_WAIT_V(6); PG8_BAR;
    for (;;) {
        const bool has_next = S.next(ui + 1, nxt);
        const char* nA = has_next ? g.A + (size_t)nxt.pm * g.a_tstep + (size_t)(nxt.pm >> 6) * g.a_pad : cA; const char* nB = has_next ? g.Bt + (size_t)nxt.pn * g.b_tstep : cB;
        int landed_flag = fresh ? 1 : 0;
        for (int th = 0; th < nt; th += (Epi::MIDK ? nt / 2 : nt)) {
        if constexpr (Epi::MIDK) { if (th) E.midk(acc, ui, wr, fr); }
        for (int t = th; t < th + (Epi::MIDK ? nt / 2 : nt); t += 2) {
            const bool last = (t == nt - 2);
            const char* a1 = cA + (size_t)(t + 1) * kstep;
            const char* a2 = last ? nA : cA + (size_t)(t + 2) * kstep; const char* b2 = last ? nB : cB + (size_t)(t + 2) * kstep;
            const char* a3 = a2 + kstep; const char* b3 = b2 + kstep;
            int lf_ = EARLY_DRAIN ? __builtin_amdgcn_readfirstlane(landed_flag) : landed_flag; if constexpr (EARLY_DRAIN) asm volatile("" : "+s"(lf_)); landed_flag = 0;
            PG8_LDB(B0, 0, 0); PG8_LDB(B1, 0, 1); PG8_SCHED; PG8_LDA(At, 0, 0); PG8_STAGE(PG8_SA(1, 1), a1 + ahs, voffA);
            if (!lf_) PG8_WAIT_V(8);
            PG8_WAIT_L(0); PG8_BAR; PG8_MMA(0, 0, At, B0); PG8_MMA(0, 1, At, B1); PG8_BAR; PG8_SCHED;
            PG8_LDA(At, 0, 1); PG8_STAGE(PG8_SB(0, 0), b2, voffB); PG8_STAGE(PG8_SB(0, 1), b2 + bhs, voffB); PG8_STAGE(PG8_SA(0, 0), a2, voffA);
            if (!lf_) PG8_WAIT_V(8);
            PG8_WAIT_L(0); PG8_BAR; PG8_MMA(1, 0, At, B0); PG8_MMA(1, 1, At, B1); PG8_BAR; PG8_SCHED;
            PG8_LDB(B0, 1, 0); PG8_LDB(B1, 1, 1); PG8_SCHED; PG8_LDA(At, 1, 0); PG8_STAGE(PG8_SA(0, 1), a2 + ahs, voffA);
            if (!lf_) PG8_WAIT_V(8);
            PG8_WAIT_L(0); PG8_BAR; PG8_MMA(0, 0, At, B0); PG8_MMA(0, 1, At, B1); PG8_BAR; PG8_SCHED;
            PG8_LDA(At, 1, 1); PG8_STAGE(PG8_SB(1, 0), b3, voffB); PG8_STAGE(PG8_SB(1, 1), b3 + bhs, voffB); PG8_STAGE(PG8_SA(1, 0), a3, voffA);
            PG8_WAIT_V(8); PG8_WAIT_L(0); PG8_BAR; PG8_MMA(1, 0, At, B0); PG8_MMA(1, 1, At, B1); PG8_BAR; PG8_SCHED;
        }
        }
        if constexpr (ALIGN_EPI) { if (wr == 0) PG8_BAR; }
        if constexpr (EARLY_DRAIN) {
            PG8_STAGE(PG8_SA(1, 1), nA + kstep + ahs, voffA); if constexpr (!Epi::OWN_DRAIN) PG8_WAIT_V(0);
        }
        { int et_ = lane_now(); asm volatile("" : "+v"(et_)); const int efr = et_ & 15, efq = et_ >> 4;
          E(acc, cur, ui, wr, wc, efr, efq); }
        if (!has_next) break;
#pragma unroll
        for (int a = 0; a < 2; ++a)
#pragma unroll
            for (int b = 0; b < 2; ++b)
#pragma unroll
                for (int m = 0; m < 4; ++m)
#pragma unroll
                    for (int n = 0; n < 2; ++n) acc[a][b][m][n] = (f32x4){0.f, 0.f, 0.f, 0.f};
        cur = nxt; cA = nA; cB = nB; ++ui; fresh = EARLY_DRAIN;
        if constexpr (Epi::HOOK) { int ht_ = lane_now(); asm volatile("" : "+v"(ht_)); E.unit_start(cur, ui, wid, ht_); }
        if constexpr (ALIGN_EPI) { if (wr == 1) PG8_BAR; }
    }
    PG8_WAIT_V(0);
    if constexpr (!ALIGN_EPI) { if (wr == 0) PG8_BAR; }
    PG8_BAR;
#undef PG8_SA
#undef PG8_SB
#undef PG8_STAGE
#undef PG8_LDA
#undef PG8_LDB
#undef PG8_MMA
#undef PG8_WAIT_V
#undef PG8_WAIT_V8_UNLESS
#undef PG8_WAIT_L
#undef PG8_BAR
#undef PG8_SCHED
}

struct EpiProj {
    static constexpr bool MIDK = false, HOOK = false, OWN_DRAIN = false;
    bf16_t* O; const LAS float* rs;
    __device__ __forceinline__ void operator()(const f32x4 (&acc)[2][2][4][2], const Unit& u, int ui, int wr, int wc, int fr, int fq) const {
        const float sct = (u.pn < 2 || u.pn == 6 || u.pn == 7) ? C2 : 1.0f;
        const LAS float* rsu = rs + ui * 256;
#pragma unroll
        for (int ai = 0; ai < 2; ++ai)
#pragma unroll
            for (int m = 0; m < 4; ++m) { const int row = ai * HALF + wr * 64 + m * 16 + fr; const float sc = rsu[row] * sct;
                bf16_t* rowp = O + (size_t)(u.pm * BM + row) * NIN + u.pn * BM + wc * 32 + 8 * fq;
#pragma unroll
                for (int bj = 0; bj < 2; ++bj) { const f32x4 v0 = acc[ai][bj][m][0] * sc, v1 = acc[ai][bj][m][1] * sc;
                    u32x4 w; w.x = cvtpk(v0[0], v0[1]); w.y = cvtpk(v0[2], v0[3]); w.z = cvtpk(v1[0], v1[1]); w.w = cvtpk(v1[2], v1[3]);
                    *(u32x4*)(rowp + bj * HALF) = w; } }
    }
};
__device__ __forceinline__ float bf_lo(unsigned w) { return __uint_as_float(w << 16); }
__device__ __forceinline__ float bf_hi(unsigned w) { return __uint_as_float(w & 0xffff0000u); }
template <bool GRP> struct EpiRes {
    static constexpr bool MIDK = GRP, HOOK = false, OWN_DRAIN = false;
    bf16_t* xb; float* ssx; const LAS f32x2* rs2;
    __device__ __forceinline__ void midk(f32x4 (&acc)[2][2][4][2], int ui, int wr, int fr) const {
        const LAS f32x2* rsu = rs2 + ui * 256;
#pragma unroll
        for (int ai = 0; ai < 2; ++ai)
#pragma unroll
            for (int m = 0; m < 4; ++m) { const float ra = rsu[ai * HALF + wr * 64 + m * 16 + fr].x;
#pragma unroll
                for (int bj = 0; bj < 2; ++bj)
#pragma unroll
                    for (int n = 0; n < 2; ++n) acc[ai][bj][m][n] *= ra; }
    }
    __device__ __forceinline__ void operator()(const f32x4 (&acc)[2][2][4][2], const Unit& u, int ui, int wr, int wc, int fr, int fq) const {
        const int row0 = wr * 64 + fr, col0 = u.pn * BM + wc * 32 + 8 * fq;
        GAS bf16_t* xp0 = (GAS bf16_t*)xb + (size_t)(u.pm * BM + (u.pm >> 6) + row0) * D + col0;
        GAS float* sp = (GAS float*)ssx + (size_t)(u.pm * BM + row0) * 16 + u.pn * 4 + wc;
        const LAS f32x2* rsu = rs2 + ui * 256 + row0;
        u32x4 rw[2][4][2];
#pragma unroll
        for (int ai = 0; ai < 2; ++ai)
#pragma unroll
            for (int m = 0; m < 4; ++m)
#pragma unroll
                for (int bj = 0; bj < 2; ++bj) rw[ai][m][bj] = *(const GAS u32x4*)(xp0 + (size_t)(ai * HALF + m * 16) * D + bj * HALF);
        GAS bf16_t* xp = xp0;
#pragma unroll
        for (int ai = 0; ai < 2; ++ai)
#pragma unroll
            for (int m = 0; m < 4; ++m) {
                float sc = 1.0f; if constexpr (GRP) sc = rsu[ai * HALF + m * 16].y;
                float ss = 0.f;
#pragma unroll
                for (int bj = 0; bj < 2; ++bj) {
                    const u32x4 r = rw[ai][m][bj];
                    const f32x4 r0 = (f32x4){bf_lo(r.x), bf_hi(r.x), bf_lo(r.y), bf_hi(r.y)}, r1 = (f32x4){bf_lo(r.z), bf_hi(r.z), bf_lo(r.w), bf_hi(r.w)};
                    const f32x4 v0 = r0 + acc[ai][bj][m][0] * sc, v1 = r1 + acc[ai][bj][m][1] * sc;
                    u32x4 w; w.x = cvtpk(v0[0], v0[1]); w.y = cvtpk(v0[2], v0[3]); w.z = cvtpk(v1[0], v1[1]); w.w = cvtpk(v1[2], v1[3]);
                    *(GAS u32x4*)(xp + bj * HALF) = w;
                    ss += (v0[0] * v0[0] + v0[1] * v0[1]) + (v0[2] * v0[2] + v0[3] * v0[3]) + (v1[0] * v1[0] + v1[1] * v1[1]) + (v1[2] * v1[2] + v1[3] * v1[3]); }
                ss = sum_x16_x32(ss);
                if (fq == 0) *sp = ss;
                const int adv = (m == 3) ? (HALF - 48) : 16;
                xp += (size_t)adv * D; sp += adv * 16;
                asm volatile("" : "+v"(xp), "+v"(sp)); }
    }
};
struct EpiFin {
    static constexpr bool MIDK = false, HOOK = false, OWN_DRAIN = false;
    const bf16_t* xb; float* out; const float* gfin; float* xslot; unsigned* cnt; LAS unsigned char* scr;
    __device__ __forceinline__ void operator()(f32x4 (&acc)[2][2][4][2], const Unit& u, int ui, int wr, int wc, int fr, int fq) const {
        int tid_ = (wr * 4 + wc) * 64 + lane_now(); asm volatile("" : "+v"(tid_)); const int tid = tid_, lane = tid & 63;
        const int row0 = wr * 64 + fr, col0 = u.pn * BM + wc * 32 + 8 * fq;
        const GAS bf16_t* xp0 = (const GAS bf16_t*)xb + (size_t)(u.pm * BM + (u.pm >> 6) + row0) * D + col0;
        LAS float* P = (LAS float*)scr; LAS float* S = (LAS float*)(scr + 4096); volatile LAS unsigned* flag = (volatile LAS unsigned*)(scr + 5120);
        u32x4 rw[2][4][2];
#pragma unroll
        for (int ai = 0; ai < 2; ++ai)
#pragma unroll
            for (int m = 0; m < 4; ++m)
#pragma unroll
                for (int bj = 0; bj < 2; ++bj) rw[ai][m][bj] = *(const GAS u32x4*)(xp0 + (size_t)(ai * HALF + m * 16) * D + bj * HALF);
#pragma unroll
        for (int ai = 0; ai < 2; ++ai)
#pragma unroll
            for (int m = 0; m < 4; ++m) { float ss = 0.f;
#pragma unroll
                for (int bj = 0; bj < 2; ++bj) { const u32x4 r = rw[ai][m][bj];
                    acc[ai][bj][m][0] += (f32x4){bf_lo(r.x), bf_hi(r.x), bf_lo(r.y), bf_hi(r.y)}; acc[ai][bj][m][1] += (f32x4){bf_lo(r.z), bf_hi(r.z), bf_lo(r.w), bf_hi(r.w)};
                    const f32x4 v0 = acc[ai][bj][m][0], v1 = acc[ai][bj][m][1];
                    ss += (v0[0] * v0[0] + v0[1] * v0[1]) + (v0[2] * v0[2] + v0[3] * v0[3]) + (v1[0] * v1[0] + v1[1] * v1[1]) + (v1[2] * v1[2] + v1[3] * v1[3]); }
                ss = sum_x16_x32(ss);
                if (fq == 0) P[(ai * HALF + row0 + m * 16) * 4 + wc] = ss; }
        asm volatile("s_waitcnt lgkmcnt(0)" ::: "memory"); __builtin_amdgcn_s_barrier(); asm volatile("" ::: "memory");
        GAS float* slot = (GAS float*)xslot + ((size_t)u.pm * 256) * 4;
        if (tid < 256) { const f32x4 p = *(const LAS f32x4*)(P + tid * 4);
            __hip_atomic_store(slot + tid * 4 + u.pn, (p[0] + p[1]) + (p[2] + p[3]), __ATOMIC_RELAXED, __HIP_MEMORY_SCOPE_AGENT); }
        asm volatile("s_waitcnt vmcnt(0)" ::: "memory"); __builtin_amdgcn_s_barrier(); asm volatile("" ::: "memory");
        if (tid == 0) {
            __hip_atomic_fetch_add(cnt + 64 * u.pm, 1u, __ATOMIC_RELAXED, __HIP_MEMORY_SCOPE_AGENT);
            unsigned sp = 0, ok = 1;
            while (__hip_atomic_load(cnt + 64 * u.pm, __ATOMIC_RELAXED, __HIP_MEMORY_SCOPE_AGENT) < 4u) { __builtin_amdgcn_s_sleep(2); if (++sp > (1u << 22)) { ok = 0; break; } }
            __builtin_amdgcn_fence(__ATOMIC_ACQUIRE, "agent");
            flag[0] = ok;
        }
        asm volatile("s_waitcnt vmcnt(0) lgkmcnt(0)" ::: "memory"); __builtin_amdgcn_s_barrier(); asm volatile("" ::: "memory");
        if (tid < 256) { float t = 0.f;
#pragma unroll
            for (int k = 0; k < 4; ++k) t += __hip_atomic_load(slot + tid * 4 + k, __ATOMIC_RELAXED, __HIP_MEMORY_SCOPE_AGENT);
            S[tid] = (flag[0] != 0u) ? 1.0f / sqrtf(t * (1.0f / D) + EPS) : __builtin_nanf(""); }
        asm volatile("s_waitcnt vmcnt(0) lgkmcnt(0)" ::: "memory"); __builtin_amdgcn_s_barrier(); asm volatile("" ::: "memory");
        f32x4 g0[2], g1[2];
#pragma unroll
        for (int bj = 0; bj < 2; ++bj) { g0[bj] = *(const GAS f32x4*)((const GAS float*)gfin + col0 + bj * HALF); g1[bj] = *(const GAS f32x4*)((const GAS float*)gfin + col0 + bj * HALF + 4); }
        GAS float* op = (GAS float*)out + (size_t)(u.pm * BM + row0) * D + col0;
#pragma unroll
        for (int ai = 0; ai < 2; ++ai)
#pragma unroll
            for (int m = 0; m < 4; ++m) { const float iv = S[ai * HALF + row0 + m * 16];
#pragma unroll
                for (int bj = 0; bj < 2; ++bj) { *(GAS f32x4*)(op + bj * HALF) = acc[ai][bj][m][0] * iv * g0[bj]; *(GAS f32x4*)(op + bj * HALF + 4) = acc[ai][bj][m][1] * iv * g1[bj]; }
                const int adv = (m == 3) ? (HALF - 48) : 16; op += (size_t)adv * D; asm volatile("" : "+v"(op)); }
        asm volatile("s_waitcnt lgkmcnt(0)" ::: "memory"); __builtin_amdgcn_s_barrier(); asm volatile("" ::: "memory");
        (void)lane;
    }
};
struct EpiUp {
    static constexpr bool MIDK = false, HOOK = true, OWN_DRAIN = true;
    bf16_t* hid; const float* cws; const LAS float* rs; LAS unsigned char* cbuf;
    __device__ __forceinline__ void unit_start(const Unit& u, int ui, int wid, int lane) const {
        if (wid < 4) { const int a = 2 * wid + (lane >> 5);
            const float* src = cws + (size_t)(a & 3) * NUP + (a >= 4 ? DFF : 0) + u.pn * HALF + (lane & 31) * 4;
            glds16(src, (unsigned)__builtin_amdgcn_readfirstlane((unsigned)(uintptr_t)cbuf + (unsigned)((ui & 1) * 4096 + wid * 1024))); }
    }
    __device__ __forceinline__ void operator()(const f32x4 (&acc)[2][2][4][2], const Unit& u, int ui, int wr, int wc, int fr, int fq) const {
        const LAS float* rsu = rs + ui * 256 + wr * 64 + fr;
        float inv[8];
#pragma unroll
        for (int q = 0; q < 8; ++q) inv[q] = rsu[(q >> 2) * HALF + (q & 3) * 16];
        const int p0 = UPM * u.pm - 1 + 126 * wr + 8 * fr;
        const int cg = u.pn * HALF + wc * 32 + 8 * fq;
#pragma unroll
        for (int h = 0; h < 2; ++h) {
            unsigned pk[2][4][2];
#pragma unroll
            for (int n = 0; n < 2; ++n) {
                const LAS float* wl = (const LAS float*)(cbuf + (ui & 1) * 4096) + wc * 32 + 8 * fq + 4 * n;
#pragma unroll
                for (int ep = 0; ep < 2; ++ep) {
                    const LAS float* wp = wl + 2 * ep;
                    const f32x2 w0g = *(const LAS f32x2*)(wp), w1g = *(const LAS f32x2*)(wp + 128), w2g = *(const LAS f32x2*)(wp + 256), bg = *(const LAS f32x2*)(wp + 384);
                    const f32x2 w0v = *(const LAS f32x2*)(wp + 512), w1v = *(const LAS f32x2*)(wp + 640), w2v = *(const LAS f32x2*)(wp + 768), bv = *(const LAS f32x2*)(wp + 896);
                    float rr[2][4];
#pragma unroll
                    for (int e2 = 0; e2 < 2; ++e2) { const int e = 2 * ep + e2;
                        float xg[6], xv[6];
#pragma unroll
                        for (int i = 1; i < 5; ++i) { xg[i] = acc[h][0][i - 1][n][e] * inv[4 * h + i - 1]; xv[i] = acc[h][1][i - 1][n][e] * inv[4 * h + i - 1]; }
                        if (h == 0) { xg[0] = dpp_shr1(acc[1][0][3][n][e] * inv[7]); xv[0] = dpp_shr1(acc[1][1][3][n][e] * inv[7]); xg[5] = acc[1][0][0][n][e] * inv[4]; xv[5] = acc[1][1][0][n][e] * inv[4]; }
                        else        { xg[0] = acc[0][0][3][n][e] * inv[3]; xv[0] = acc[0][1][3][n][e] * inv[3]; xg[5] = dpp_shl1(acc[0][0][0][n][e] * inv[0]); xv[5] = dpp_shl1(acc[0][1][0][n][e] * inv[0]); }
#pragma unroll
                        for (int i = 1; i < 5; ++i) {
                            const float gc = __builtin_fmaf(w0g[e2], xg[i - 1], __builtin_fmaf(w1g[e2], xg[i], __builtin_fmaf(w2g[e2], xg[i + 1], bg[e2])));
                            const float vc = __builtin_fmaf(w0v[e2], xv[i - 1], __builtin_fmaf(w1v[e2], xv[i], __builtin_fmaf(w2v[e2], xv[i + 1], bv[e2])));
                            const float sg = gc * __builtin_amdgcn_rcpf(1.0f + __builtin_amdgcn_exp2f(gc));
                            rr[e2][i - 1] = sg * vc; }
                    }
#pragma unroll
                    for (int i = 0; i < 4; ++i) pk[n][i][ep] = cvtpk(rr[0][i], rr[1][i]);
                    __builtin_amdgcn_sched_barrier(0);
                }
            }
            if (h == 0) asm volatile("s_waitcnt vmcnt(0)" ::: "memory");
#pragma unroll
            for (int i = 0; i < 4; ++i) { const int q = 4 * h + i; const int j = 8 * fr + q; int p = p0 + q; asm volatile("" : "+v"(p));
                const int tok = p - (p > SEQ ? 1 : 0) - (p > 2 * SEQ + 1 ? 1 : 0);
                if (j >= 1 && j <= 126 && p < MP && p != SEQ && p != 2 * SEQ + 1) { u32x4 w; w.x = pk[0][i][0]; w.y = pk[0][i][1]; w.z = pk[1][i][0]; w.w = pk[1][i][1]; *(GAS u32x4*)((GAS bf16_t*)hid + (size_t)tok * DFF + cg) = w; } }
            __builtin_amdgcn_sched_barrier(0);
        }
    }
};
}

namespace att {
constexpr int PITCH = NIN * 2;
constexpr int SLOT = 16384;
__device__ __forceinline__ float vmax2(float a, float b) { return __builtin_elementwise_maximum(a, b); }
__device__ __forceinline__ float vmax3(float a, float b, float c) { return __builtin_elementwise_maximum(__builtin_elementwise_maximum(a, b), c); }
__device__ __forceinline__ float quad_max3(float m, float v) {
    auto a = __builtin_amdgcn_permlane16_swap(__float_as_uint(v), __float_as_uint(v), false, false); v = vmax2(__uint_as_float(a[0]), __uint_as_float(a[1]));
    auto b = __builtin_amdgcn_permlane32_swap(__float_as_uint(v), __float_as_uint(v), false, false); return vmax3(m, __uint_as_float(b[0]), __uint_as_float(b[1])); }
__device__ __forceinline__ float quad_sum(float v) {
    auto a = __builtin_amdgcn_permlane16_swap(__float_as_uint(v), __float_as_uint(v), false, false); v = __uint_as_float(a[0]) + __uint_as_float(a[1]);
    auto b = __builtin_amdgcn_permlane32_swap(__float_as_uint(v), __float_as_uint(v), false, false); return __uint_as_float(b[0]) + __uint_as_float(b[1]); }
#define WJ(j) ((j) == 0 ? 0 : (j) == 1 ? 8 : (j) == 2 ? 24 : 32)
template <int MODE>
__device__ __forceinline__ void block_unit(LAS unsigned char* ring, const bf16_t* proj, bf16_t* attn, float* ssa, int lane_, int wave,
                                           int ktok0, int nT, int kcol, int vcol, int act0, int actn,
                                           int qtok0, int half, int qcol, const LAS f32x4* bcp, int dr0, float slope2, float sink2, int outcol, int sscol,
                                           int& rbase, const bool pre, const char* nK, const char* nV, const bf16_t* nQ, bf16x8 (&qf)[2][2]) {
    int lane = lane_; asm volatile("" : "+v"(lane));
    const int qi = lane & 15, g = lane >> 4;
    const int rl = lane >> 3, cl = lane & 7;
    const unsigned loffk = (unsigned)((8 * wave + rl) * PITCH + ((cl ^ ((4 * (wave & 1) + (lane >> 4)) & 7)) << 4)), loffv = (unsigned)((8 * wave + rl) * PITCH + ((cl ^ (2 * (lane >> 4))) << 4));
    const char* kg = (const char*)(proj + (size_t)ktok0 * NIN + kcol);
    const char* vg = (const char*)(proj + (size_t)ktok0 * NIN + vcol);
    const unsigned ring0 = (unsigned)(uintptr_t)ring + (unsigned)wave * 1024u;
    const int base = rbase;
#define DMA_TILE(t) do { const unsigned sl_ = (unsigned)__builtin_amdgcn_readfirstlane(ring0 + (unsigned)(((t) + base) % 3) * SLOT); \
        glds16kv(loffk, loffv, kg + (size_t)(t) * 64 * PITCH, vg + (size_t)(t) * 64 * PITCH, sl_); } while (0)
#define DMA_NEXT(i) do { const unsigned sl_ = (unsigned)__builtin_amdgcn_readfirstlane(ring0 + (unsigned)((nT + (i) + base) % 3) * SLOT); \
        glds16kv(loffk, loffv, nK + (size_t)(i) * 64 * PITCH, nV + (size_t)(i) * 64 * PITCH, sl_); } while (0)
    const size_t qoff = (size_t)qi * NIN + 8 * g;
    if (!pre) { DMA_TILE(0); DMA_TILE(1);
#pragma unroll
        for (int jj = 0; jj < 2; ++jj)
#pragma unroll
            for (int ks = 0; ks < 2; ++ks) qf[jj][ks] = *(const GAS bf16x8*)((const GAS bf16_t*)proj + (size_t)(qtok0 + 16 * jj) * NIN + qcol + 32 * ks + qoff);
        __builtin_amdgcn_s_waitcnt(0x0F70);
    } else {
        __builtin_amdgcn_s_waitcnt(0x0F78);
    }
    f32x4 o[2][4];
    float mrun[2], lrun[2];
#pragma unroll
    for (int jj = 0; jj < 2; ++jj) {
#pragma unroll
        for (int dt = 0; dt < 4; ++dt) o[jj][dt] = (f32x4){0.f, 0.f, 0.f, 0.f};
        mrun[jj] = (MODE == 1) ? sink2 : -1e30f; lrun[jj] = (MODE == 1 && g == 0) ? 1.0f : 0.0f; }
    const int va = (lane & 15) >> 2, vb = lane & 3, sv = (2 * (g & 1) + (va >> 1)) & 3;
    int kofs[2], kad[2][2], vad[2], relm[2], bofs[2];
#pragma unroll
    for (int jj = 0; jj < 2; ++jj) {
        const int j = 2 * half + jj; const int koff = (MODE == 1) ? 0 : ((j == 0) ? 0 : (j == 1) ? 8 : (j == 2) ? 24 : 32);
        const int par = (koff >> 3) & 1, s0 = g ^ (qi >> 1);
        kofs[jj] = koff;
        kad[jj][0] = (koff + qi) * 128 + ((s0 ^ (4 * par)) << 4); kad[jj][1] = (koff + qi) * 128 + ((s0 ^ (4 * par) ^ 4) << 4);
        vad[jj] = 8192 + (koff + 4 * g + va) * 128 + vb * 8;
        const int c = 16 * j + qi, cs = min(max(c - 8, 0), 48);
        relm[jj] = koff + 4 * g - cs;
        const int raw = (MODE == 1) ? (ktok0 - (qtok0 + 16 * jj + qi) + 4 * g + 191) : (koff + 4 * g - c + 15 + 16); const int s4 = (3 - qi) & 3;
        bofs[jj] = s4 * ((MODE == 0) ? 968 : 768) + ((raw - s4) >> 2); }
    const float NEG = -INFINITY;
    f32x4 mneg[2][2];
#pragma unroll
    for (int jj = 0; jj < 2; ++jj)
#pragma unroll
        for (int kt = 0; kt < 2; ++kt)
#pragma unroll
            for (int e = 0; e < 4; ++e) mneg[jj][kt][e] = (MODE == 0 && !((unsigned)(relm[jj] + 16 * kt + e) < 16u)) ? NEG : 0.f;
    constexpr int NH = (MODE == 1) ? 2 : 1;
    auto head = [&](const int t) __attribute__((always_inline)) {
        if (t >= 2) { if (t + 1 < nT || nK) asm volatile("s_waitcnt vmcnt(2)" ::: "memory"); else asm volatile("s_waitcnt vmcnt(0)" ::: "memory"); }
        __builtin_amdgcn_s_barrier();
        if (t + 2 < nT) DMA_TILE(t + 2); else if (nK) DMA_NEXT(t + 2 - nT);
    };
    auto body = [&](const int t) __attribute__((always_inline)) {
        if (t >= act0 && t < act0 + actn) {
        const LAS unsigned char* Sl = ring + ((t + base) % 3) * SLOT;
#pragma unroll
        for (int hf = 0; hf < NH; ++hf) {
            if (MODE == 1) { const int ks = ktok0 + 64 * t + 32 * hf;
                if (ks + 31 < qtok0 - 128 || ks > qtok0 + 31 + 128) continue; }
            bf16x8 kf[2][2][2];
#pragma unroll
            for (int jj = 0; jj < 2; ++jj)
#pragma unroll
                for (int kt = 0; kt < 2; ++kt)
#pragma unroll
                    for (int ks = 0; ks < 2; ++ks) kf[jj][kt][ks] = *(const LAS bf16x8*)(Sl + kad[jj][ks] + (32 * hf + 16 * kt) * 128);
            f32x4 bb[2][2];
#pragma unroll
            for (int jj = 0; jj < 2; ++jj) { const LAS f32x4* bl = bcp + ((MODE == 0) ? (dr0 + t - act0) * 8 : 16 * t + 8 * hf) + bofs[jj];
#pragma unroll
                for (int kt = 0; kt < 2; ++kt) bb[jj][kt] = bl[4 * kt]; }
            s16x4 vlo[2][4], vhi[2][4];
#pragma unroll
            for (int jj = 0; jj < 2; ++jj)
#pragma unroll
                for (int dt = 0; dt < 4; ++dt) { const LAS unsigned char* vp = Sl + vad[jj] + (32 * hf) * 128 + ((dt ^ sv) << 5);
                    vlo[jj][dt] = __builtin_bit_cast(s16x4, __builtin_amdgcn_ds_read_tr16_b64_v4i16((LAS s16x4*)(vp)));
                    vhi[jj][dt] = __builtin_bit_cast(s16x4, __builtin_amdgcn_ds_read_tr16_b64_v4i16((LAS s16x4*)(vp + 2048))); }
            __builtin_amdgcn_sched_barrier(0);
            f32x4 s[2][2];
#pragma unroll
            for (int jj = 0; jj < 2; ++jj)
#pragma unroll
                for (int kt = 0; kt < 2; ++kt) { f32x4 a = (MODE == 0) ? bb[jj][kt] + mneg[jj][kt] : bb[jj][kt];
                    a = __builtin_amdgcn_mfma_f32_16x16x32_bf16(kf[jj][kt][0], qf[jj][0], a, 0, 0, 0);
                    s[jj][kt] = __builtin_amdgcn_mfma_f32_16x16x32_bf16(kf[jj][kt][1], qf[jj][1], a, 0, 0, 0); }
            u32x4 pw[2];
#pragma unroll
            for (int jj = 0; jj < 2; ++jj) {
                const float tm = vmax3(vmax3(s[jj][0][0], s[jj][0][1], s[jj][0][2]), vmax3(s[jj][0][3], s[jj][1][0], s[jj][1][1]), vmax3(s[jj][1][2], s[jj][1][3], s[jj][1][3]));
                const float mn = quad_max3(mrun[jj], tm);
                const float alpha = __builtin_amdgcn_exp2f(mrun[jj] - mn);
                mrun[jj] = mn;
                float rsum = 0.f;
#pragma unroll
                for (int kt = 0; kt < 2; ++kt)
#pragma unroll
                    for (int e = 0; e < 4; ++e) { s[jj][kt][e] = __builtin_amdgcn_exp2f(s[jj][kt][e] - mn); rsum += s[jj][kt][e]; }
                lrun[jj] = lrun[jj] * alpha + rsum;
#pragma unroll
                for (int dt = 0; dt < 4; ++dt) o[jj][dt] *= alpha;
                pw[jj].x = cvtpk(s[jj][0][0], s[jj][0][1]); pw[jj].y = cvtpk(s[jj][0][2], s[jj][0][3]); pw[jj].z = cvtpk(s[jj][1][0], s[jj][1][1]); pw[jj].w = cvtpk(s[jj][1][2], s[jj][1][3]);
            }
#pragma unroll
            for (int jj = 0; jj < 2; ++jj)
#pragma unroll
                for (int dt = 0; dt < 4; ++dt) {
                    const bf16x8 vf = (bf16x8){vlo[jj][dt][0], vlo[jj][dt][1], vlo[jj][dt][2], vlo[jj][dt][3], vhi[jj][dt][0], vhi[jj][dt][1], vhi[jj][dt][2], vhi[jj][dt][3]};
                    o[jj][dt] = __builtin_amdgcn_mfma_f32_16x16x32_bf16(vf, __builtin_bit_cast(bf16x8, pw[jj]), o[jj][dt], 0, 0, 0); }
            __builtin_amdgcn_sched_barrier(0);
        }
        }
    };
    for (int t = 0; t < nT - 1; ++t) { head(t); body(t); }
    head(nT - 1);
    bf16x8 qn[2][2];
    { const GAS bf16_t* qs = nQ ? (const GAS bf16_t*)nQ : (const GAS bf16_t*)proj + (size_t)qtok0 * NIN + qcol;
#pragma unroll
      for (int jj = 0; jj < 2; ++jj)
#pragma unroll
          for (int ks = 0; ks < 2; ++ks) qn[jj][ks] = *(const GAS bf16x8*)(qs + (size_t)(16 * jj) * NIN + 32 * ks + qoff); }
    body(nT - 1);
#undef DMA_TILE
#undef DMA_NEXT
    rbase = (base + nT) % 3;
    {
#pragma unroll
    for (int jj = 0; jj < 2; ++jj) {
        const float lt = quad_sum(lrun[jj]); const float il = 1.0f / lt;
        const int tok = qtok0 + 16 * jj + qi;
        float ss = 0.f;
#pragma unroll
        for (int dt = 0; dt < 4; ++dt) { const f32x4 v = o[jj][dt] * il;
            ss += (v[0] * v[0] + v[1] * v[1]) + (v[2] * v[2] + v[3] * v[3]);
            u32x2 w; w.x = cvtpk(v[0], v[1]); w.y = cvtpk(v[2], v[3]);
            *(GAS u32x2*)((GAS bf16_t*)attn + (size_t)tok * D + outcol + 16 * dt + 4 * g) = w; }
        ss = quad_sum(ss);
        if (g == 0) ((GAS float*)ssa)[(size_t)tok * 16 + sscol] = ss;
    }
    }
#pragma unroll
    for (int jj = 0; jj < 2; ++jj)
#pragma unroll
        for (int ks = 0; ks < 2; ++ks) { qf[jj][ks] = qn[jj][ks]; asm volatile("" : "+v"(qf[jj][ks])); }
    __builtin_amdgcn_s_barrier();
}
#undef WJ
}

#define XB_TMO      128
#define XB_XCNT(j)  (256  + 64 * (j))
#define XB_XSUB(j)  (1280 + 64 * (j))
#define XB_XGEN(j)  (2304 + 64 * (j))
#define XB_TOP      3328
#define XB_TOPGEN   3392
#define XCD_BAR_WORDS 3456
#define XB_SPIN_CAP (1u << 20)
__device__ __forceinline__ unsigned xb_ld(unsigned* p)              { return __hip_atomic_load(p, __ATOMIC_RELAXED, __HIP_MEMORY_SCOPE_AGENT); }
__device__ __forceinline__ unsigned xb_add(unsigned* p, unsigned v) { return __hip_atomic_fetch_add(p, v, __ATOMIC_RELAXED, __HIP_MEMORY_SCOPE_AGENT); }
__device__ __forceinline__ unsigned xb_xcc_id() { return (unsigned)__builtin_amdgcn_s_getreg((3 << 11) | 20) & 0xFu; }
#define XB_SPIN(cond, bar) do { unsigned _sp = 0; while (cond) { __builtin_amdgcn_s_sleep(1); \
    if ((++_sp & 255u) == 0u) { if (xb_ld(&(bar)[XB_TMO])) break; if (_sp > XB_SPIN_CAP) { atomicAdd(&(bar)[XB_TMO], 1u); break; } } } } while (0)
struct XcdBarrier { unsigned* bar; unsigned x; volatile LAS unsigned* st; };
__device__ __forceinline__ XcdBarrier xcd_barrier_post(unsigned* bar, volatile LAS unsigned* st) {
    XcdBarrier b; b.bar = bar; b.x = xb_xcc_id(); b.st = st;
    if (threadIdx.x == 0) (void)xb_add(&bar[XB_XCNT(b.x)], 1u);
    return b;
}
__device__ __forceinline__ void xcd_barrier_complete(unsigned* bar, unsigned x, unsigned& nloc, unsigned& nx) {
    const unsigned G = gridDim.x * gridDim.y * gridDim.z;
    unsigned sum, cnt, mine, sp = 0u;
    for (;;) {
        sum = 0u; cnt = 0u; mine = 0u;
#pragma unroll
        for (unsigned j = 0; j < 16; ++j) { const unsigned c = xb_ld(&bar[XB_XCNT(j)]); sum += c; cnt += (c > 0u) ? 1u : 0u; mine = (j == x) ? c : mine; }
        if (sum == G) break;
        __builtin_amdgcn_s_sleep(1);
        if ((++sp & 255u) == 0u) { if (xb_ld(&bar[XB_TMO])) break; if (sp > XB_SPIN_CAP) { atomicAdd(&bar[XB_TMO], 1u); break; } }
    }
    nloc = mine > 0u ? mine : 1u; nx = cnt > 0u ? cnt : 1u;
}
__device__ __forceinline__ void xcd_barrier(const XcdBarrier& b, int wv) {
    asm volatile("s_waitcnt vmcnt(0)" ::: "memory");
    __syncthreads();
    if (wv == 0 && lane_now() == 0) {
        unsigned* bar = b.bar;
        __builtin_amdgcn_s_waitcnt(0);
        unsigned nloc = b.st[0], nx = b.st[1];
        if (nloc == 0u) { xcd_barrier_complete(bar, b.x, nloc, nx); b.st[0] = nloc; b.st[1] = nx; }
        const unsigned old = xb_add(&bar[XB_XSUB(b.x)], 1u);
        const unsigned gen = old / nloc;
        if (old + 1u == (gen + 1u) * nloc) {
            __builtin_amdgcn_fence(__ATOMIC_RELEASE, "agent");
            asm volatile("s_waitcnt vmcnt(0)" ::: "memory");
            const unsigned og = xb_add(&bar[XB_TOP], 1u);
            const unsigned tg = og / nx;
            if (og + 1u == (tg + 1u) * nx) xb_add(&bar[XB_TOPGEN], 1u);
            else XB_SPIN(xb_ld(&bar[XB_TOPGEN]) == tg, bar);
            __builtin_amdgcn_fence(__ATOMIC_ACQUIRE, "agent");
            xb_add(&bar[XB_XGEN(b.x)], 1u);
            asm volatile("s_waitcnt vmcnt(0)" ::: "memory");
        } else {
            XB_SPIN(xb_ld(&bar[XB_XGEN(b.x)]) == gen, bar);
            __builtin_amdgcn_fence(__ATOMIC_ACQUIRE, "agent");
            asm volatile("s_waitcnt vmcnt(0)" ::: "memory");
        }
    }
    __syncthreads();
}

struct Args { const float* in[14]; float* out; unsigned char* ws; int ph_lo, ph_hi, li, pad; };
constexpr int N_PHASES = 2 + 5 * DEPTH;

__device__ __forceinline__ void transpose_item(const float* W, const float* gain, int K, int N, bf16_t* WT, LAS float* scr, int item, int lane) {
    const int nblk = N / 32, kb = item / nblk, nb = item % nblk, k0 = 64 * kb, n0 = 32 * nb;
    f32x4 wv[8]; float gk[8];
#pragma unroll
    for (int i = 0; i < 8; ++i) { const int kk = (lane >> 3) + 8 * i; wv[i] = *(const GAS f32x4*)((const GAS float*)W + (size_t)(k0 + kk) * N + n0 + 4 * (lane & 7)); gk[i] = gain ? gain[k0 + kk] : 1.0f; }
#pragma unroll
    for (int i = 0; i < 8; ++i) { const int kk = (lane >> 3) + 8 * i; LAS float* d = scr + kk * 33 + 4 * (lane & 7);
        d[0] = wv[i][0] * gk[i]; d[1] = wv[i][1] * gk[i]; d[2] = wv[i][2] * gk[i]; d[3] = wv[i][3] * gk[i]; }
    LDS_WAIT(); asm volatile("" ::: "memory");
    const int c = lane & 7;
#pragma unroll
    for (int j = 0; j < 4; ++j) { const int n = (lane >> 3) + 8 * j; const LAS float* s = scr + (8 * c) * 33 + n;
        u32x4 o; o.x = cvtpk(s[0 * 33], s[1 * 33]); o.y = cvtpk(s[2 * 33], s[3 * 33]); o.z = cvtpk(s[4 * 33], s[5 * 33]); o.w = cvtpk(s[6 * 33], s[7 * 33]);
        *(u32x4*)(WT + (size_t)(n0 + n) * K + k0 + 8 * c) = o; }
    LDS_WAIT(); asm volatile("" ::: "memory");
}

__global__ void __launch_bounds__(NWAVES * 64, 2) fwd_kernel(Args args) {
    extern __shared__ __attribute__((aligned(16))) unsigned char lds_raw[];
    LAS unsigned char* lds = (LAS unsigned char*)lds_raw;
    volatile LAS unsigned* MISC = (volatile LAS unsigned*)(lds + MISC_OFF);
    const int G = gridDim.x; const int bx = blockIdx.x; const int vcu = (G % 8 == 0) ? (bx % 8) * (G / 8) + bx / 8 : bx;
    unsigned char* ws = args.ws;
    unsigned* ctl = (unsigned*)(ws + WS_CTL);
    const float* x_p = args.in[0]; const float* x_s = args.in[1];
    const float* norm_mix = args.in[2]; const float* w_in = args.in[3]; const float* rpb = args.in[4]; const float* sinks = args.in[5];
    const float* norm_grp = args.in[6]; const float* w_out = args.in[7]; const float* norm_ffn = args.in[8]; const float* w_up = args.in[9];
    const float* conv_w = args.in[10]; const float* conv_b = args.in[11]; const float* w_down = args.in[12]; const float* norm_final = args.in[13];
    float* out = args.out;
    bf16_t* XB = (bf16_t*)(ws + WS_XB); float* SSX = (float*)(ws + WS_SSX); float* SSA = (float*)(ws + WS_SSA);
    bf16_t* PROJ = (bf16_t*)(ws + WS_PROJ); bf16_t* ATT = (bf16_t*)(ws + WS_ATT); bf16_t* HID = (bf16_t*)(ws + WS_HID);

    const int wave_s = __builtin_amdgcn_readfirstlane((int)(threadIdx.x >> 6));
    for (int u = threadIdx.x; u < 256; u += NWAVES * 64) ((LAS unsigned*)(lds + MISC_OFF))[u] = 0u;
    __syncthreads();
    XcdBarrier bar; bar.bar = ctl + CW_BAR; bar.x = 0; bar.st = nullptr;
    if (MK_N_LAUNCHES == 1) bar = xcd_barrier_post(ctl + CW_BAR, MISC + 8);
    const int lo = args.ph_lo, hi_ph = args.ph_hi;
#define PHASE_IDS int tid_ = wave_s * 64 + lane_now(); asm volatile("" : "+v"(tid_) :: "memory"); const int tid = tid_, lane = tid & 63, wave = wave_s; const int gw = vcu * NWAVES + wave, NGW = G * NWAVES; (void)lane; (void)gw; (void)NGW
#ifndef PH_MASK
#define PH_MASK 0x7f
#endif
#define KIND(k) ((k) == 0 ? 0 : ((k) == N_PHASES - 1 ? 6 : 1 + ((k) - 1) % 5))
#define IN(k) (((PH_MASK >> KIND(k)) & 1) && lo <= (k) && (k) < hi_ph)
#define SEAM(k) do { if (IN(k) && IN((k) + 1)) xcd_barrier(bar, wave_s); } while (0)

    for (int rep = 0; rep <= ((REP_MASK >> 0) & 1); ++rep) if (IN(0)) {
        PHASE_IDS;
        LAS float* scr = (LAS float*)(lds + wave * 16384);
        constexpr int I_IN = (D / 64) * (NIN / 32), I_OUT = (D / 64) * (D / 32), I_UP = (D / 64) * (NUP / 32), I_DN = (DFF / 64) * (D / 32), I_L = I_IN + I_OUT + I_UP + I_DN;
        for (int it = gw; it < DEPTH * I_L; it += NGW) {
            const int l = it / I_L; int r = it % I_L;
            unsigned char* wl = ws + WS_W + (size_t)l * W_LAYER_B;
            if (r < I_IN) { transpose_item(w_in + (size_t)l * D * NIN, norm_mix + l * D, D, NIN, (bf16_t*)wl, scr, r, lane); continue; } r -= I_IN;
            if (r < I_OUT) { transpose_item(w_out + (size_t)l * D * D, norm_grp + l * D, D, D, (bf16_t*)(wl + W_IN_B), scr, r, lane); continue; } r -= I_OUT;
            if (r < I_UP) { transpose_item(w_up + (size_t)l * D * NUP, norm_ffn + l * D, D, NUP, (bf16_t*)(wl + W_IN_B + W_OUT_B), scr, r, lane); continue; } r -= I_UP;
            transpose_item(w_down + (size_t)l * DFF * D, nullptr, DFF, D, (bf16_t*)(wl + W_IN_B + W_OUT_B + W_UP_B), scr, r, lane);
        }
        for (int m0 = 4 * gw; m0 < M; m0 += 4 * NGW) {
            f32x4 v[4][4];
#pragma unroll
            for (int r = 0; r < 4; ++r) { const int m = m0 + r; const GAS float* xr = (m < SEQ) ? (const GAS float*)x_p + (size_t)m * D : (const GAS float*)x_s + (size_t)(m - SEQ) * D;
#pragma unroll
                for (int j = 0; j < 4; ++j) v[r][j] = *(const GAS f32x4*)(xr + 4 * lane + 256 * j); }
#pragma unroll
            for (int r = 0; r < 4; ++r) { const int m = m0 + r; float s = 0.f;
#pragma unroll
                for (int j = 0; j < 4; ++j) s += (v[r][j][0] * v[r][j][0] + v[r][j][1] * v[r][j][1]) + (v[r][j][2] * v[r][j][2] + v[r][j][3] * v[r][j][3]);
                s = wave_sum(s);
#pragma unroll
                for (int j = 0; j < 4; ++j) { u32x2 w; w.x = cvtpk(v[r][j][0], v[r][j][1]); w.y = cvtpk(v[r][j][2], v[r][j][3]); *(GAS u32x2*)((GAS bf16_t*)XB + (size_t)(m + m / SEQ) * D + 4 * lane + 256 * j) = w; }
                if (lane < 16) ((GAS float*)SSX)[(size_t)m * 16 + lane] = s * (1.0f / 16.0f); }
        }
        for (int i = gw * 64 + lane; i < DEPTH * 4 * NUP; i += NGW * 64) {
            const int c = i % NUP, a = (i / NUP) & 3, l2 = i / (4 * NUP);
            const float v = (a < 3) ? conv_w[((size_t)l2 * 3 + a) * NUP + c] : conv_b[(size_t)l2 * NUP + c];
            ((float*)(ws + WS_CONV))[i] = v * ((c < DFF) ? -LOG2E : -1.0f / LOG2E); }
        for (int z = gw; z < 3 + 300; z += NGW) {
            const long prow = (z == 0) ? -1 : (z == 1) ? SEQ : (z == 2) ? 2 * SEQ + 1 : (long)MP + (z - 3);
#pragma unroll
            for (int j = 0; j < 4; ++j) *(u32x2*)(XB + prow * D + 4 * lane + 256 * j) = (u32x2){0u, 0u};
        }
    }
    SEAM(0);

    for (int l = 0; l < DEPTH; ++l) {
        const int pb = 1 + 5 * l;
        const unsigned char* wl = ws + WS_W + (size_t)l * W_LAYER_B;
        const char* Win_t = (const char*)wl; const char* Wout_t = (const char*)(wl + W_IN_B); const char* Wup_t = (const char*)(wl + W_IN_B + W_OUT_B); const char* Wdn_t = (const char*)(wl + W_IN_B + W_OUT_B + W_UP_B);

        for (int rep = 0; rep <= ((REP_MASK >> 1) & 1); ++rep) if (IN(pb)) {
            PHASE_IDS;
            pg8::StaticOrder S; S.init(M / 256, NIN / 256, G, bx);
            LAS float* tab = (LAS float*)(lds + TAB_OFF);
            auto pre = [&]() __attribute__((always_inline))
            { pg8::Unit u; for (int i = wave >> 2; S.next(i, u); i += 2)       { const int row = tid & 255; const float* p = SSX + (size_t)(u.pm * 256 + row) * 16;
                const f32x4 a = *(const f32x4*)p, b = *(const f32x4*)(p + 4), c = *(const f32x4*)(p + 8), d = *(const f32x4*)(p + 12);
                const float s = ((a[0] + a[1]) + (a[2] + a[3])) + ((b[0] + b[1]) + (b[2] + b[3])) + ((c[0] + c[1]) + (c[2] + c[3])) + ((d[0] + d[1]) + (d[2] + d[3]));
                tab[i * 256 + row] = 1.0f / sqrtf(s * (1.0f / D) + EPS); } }
            ;
            pg8::Gemm g{(const char*)XB, Win_t, D, 256L * D * 2, 128L * D * 2, 256L * D * 2, 128L * D * 2, 0, (long)D * 2};
            pg8::EpiProj E{PROJ, tab};
            pg8::gemm_phase<pg8::EpiProj, true, false, decltype(pre)>(lds, g, S, E, wave, pre);
        }
        SEAM(pb);

        for (int rep = 0; rep <= ((REP_MASK >> 2) & 1); ++rep) if (IN(pb + 1)) {
            PHASE_IDS;
            LAS float* tab = (LAS float*)(lds + TAB_OFF);
            for (int i = tid; i < 8 * 15 * 32; i += NWAVES * 64) { const int h = i / 480, rem = i % 480, dr = rem >> 5, o = rem & 31;
                tab[i] = (o < 31) ? rpb[((size_t)(l * 8 + h) * 15 + dr) * 31 + o] * LOG2E : 0.f; }
            if (tid < 16) tab[8 * 15 * 32 + tid] = 0.f;
            __syncthreads();
            LAS f32x4* cpy = (LAS f32x4*)(lds + 65536);
            for (int i = tid; i < 4 * 968; i += NWAVES * 64) { const int sft = i / 968, k = i % 968; f32x4 v;
#pragma unroll
                for (int e = 0; e < 4; ++e) { const int x = 4 * k + sft + e - 16; v[e] = (x >= 0 && x < 8 * 15 * 32 + 16) ? tab[min(max(x, 0), 8 * 15 * 32 + 15)] : 0.f; }
                cpy[i] = v; }
            __syncthreads();
            int rbase = 0; bool pre = false; bf16x8 qf[2][2] = {};
            auto kbase_n = [&](int n, const char*& K0, const char*& V0) __attribute__((always_inline)) { const int r4 = n & 63, h = (n >> 6) & 7, sq = n >> 9; const int rs0 = min(max(4 * r4 - 4, 0), 248);
                const bf16_t* b = PROJ + (size_t)(sq * SEQ + rs0 * 64) * NIN; K0 = (const char*)(b + COL_KA + h * 64); V0 = (const char*)(b + COL_VA + h * 64); };
            auto kbase_s = [&](int n, const char*& K0, const char*& V0) __attribute__((always_inline)) { const int tt = n & 255, kvh = (n >> 8) & 1, sq = n >> 9; const int u_lo = max(64 * tt - 128, 0);
                const bf16_t* b = PROJ + (size_t)(sq * SEQ + u_lo) * NIN; K0 = (const char*)(b + COL_KB + kvh * 64); V0 = (const char*)(b + COL_VB + kvh * 64); };
            for (int rp = 0; rp <= ((REP_MASK >> 8) & 1); ++rp)
            for (int n = vcu; n < 1536; n += G) {
                const int r4 = n & 63, h = (n >> 6) & 7, sq = n >> 9; const int r0 = 4 * r4, r = r0 + (wave >> 1);
                const int rs0 = min(max(r0 - 4, 0), 248), rs3 = min(max(r0 - 1, 0), 248), rs = min(max(r - 4, 0), 248);
                const char* nK = nullptr; const char* nV = nullptr;
                const bf16_t* nQ = nullptr;
                if (n + G < 1536) { kbase_n(n + G, nK, nV); const int n2 = n + G; nQ = PROJ + (size_t)((n2 >> 9) * SEQ + (4 * (n2 & 63) + (wave >> 1)) * 64 + 32 * (wave & 1)) * NIN + COL_QA + ((n2 >> 6) & 7) * 64; }
                else if (REP_MASK == 0 && vcu < 1536) { kbase_s(vcu, nK, nV); const int n2 = vcu; nQ = PROJ + (size_t)((n2 >> 9) * SEQ + 64 * (n2 & 255) + 32 * (wave >> 2)) * NIN + COL_QB + (4 * ((n2 >> 8) & 1) + (wave & 3)) * 64; }
                att::block_unit<0>(lds, PROJ, ATT, SSA, lane, wave, sq * SEQ + rs0 * 64, rs3 + 8 - rs0, COL_KA + h * 64, COL_VA + h * 64, rs - rs0, 8,
                                   sq * SEQ + r * 64 + 32 * (wave & 1), wave & 1, COL_QA + h * 64, cpy + h * 120, rs - r + 7, 0.f, 0.f, h * 64, h, rbase, pre, nK, nV, nQ, qf);
                pre = (nK != nullptr);
            }
            __syncthreads();
            for (int i = tid; i < 8 * 384; i += NWAVES * 64) { const int h = i / 384, dd = abs(i % 384 - 191);
                tab[i] = (dd <= 128) ? -__builtin_amdgcn_exp2f(-(float)(h + 1)) * LOG2E * (float)dd : -INFINITY; }
            __syncthreads();
            for (int i = tid; i < 4 * 768; i += NWAVES * 64) { const int sft = i / 768, k = i % 768; f32x4 v;
#pragma unroll
                for (int e = 0; e < 4; ++e) { const int x = 4 * k + sft + e; v[e] = (x < 8 * 384) ? tab[min(x, 8 * 384 - 1)] : -INFINITY; }
                cpy[i] = v; }
            __syncthreads();
            float sinkA = sinks[l * 8 + (wave & 3)] * LOG2E, sinkB = sinks[l * 8 + 4 + (wave & 3)] * LOG2E;
            __builtin_amdgcn_s_waitcnt(0x0F70); asm volatile("" : "+v"(sinkA), "+v"(sinkB));
            for (int rp = 0; rp <= ((REP_MASK >> 9) & 1); ++rp)
            for (int n = vcu; n < 1536; n += G) {
                const int tt = n & 255, kvh = (n >> 8) & 1, sq = n >> 9; const int hb = 4 * kvh + (wave & 3), t0 = 64 * tt;
                const int u_lo = max(t0 - 128, 0), u_hi = min(t0 + 192, SEQ);
                const float slope2 = __builtin_amdgcn_exp2f(-(float)(hb + 1)) * LOG2E; const float sink2 = kvh ? sinkB : sinkA;
                const char* nK = nullptr; const char* nV = nullptr;
                const bf16_t* nQ = nullptr;
                if (n + G < 1536) { kbase_s(n + G, nK, nV); const int n2 = n + G; nQ = PROJ + (size_t)((n2 >> 9) * SEQ + 64 * (n2 & 255) + 32 * (wave >> 2)) * NIN + COL_QB + (4 * ((n2 >> 8) & 1) + (wave & 3)) * 64; }
                att::block_unit<1>(lds, PROJ, ATT, SSA, lane, wave, sq * SEQ + u_lo, (u_hi - u_lo) >> 6, COL_KB + kvh * 64, COL_VB + kvh * 64, 0, (u_hi - u_lo) >> 6,
                                   sq * SEQ + t0 + 32 * (wave >> 2), wave >> 2, COL_QB + hb * 64, cpy + hb * 96, 0, slope2, sink2, 512 + hb * 64, 8 + hb, rbase, pre, nK, nV, nQ, qf);
                pre = (nK != nullptr);
            }
            __syncthreads();
        }
        SEAM(pb + 1);

        if (IN(pb + 2)) {
            PHASE_IDS;
            pg8::StaticOrder S; S.init(M / 256, D / 256, G, bx);
            LAS f32x2* tab = (LAS f32x2*)(lds + TAB_OFF);
            auto pre = [&]() __attribute__((always_inline))
            { pg8::Unit u; for (int i = wave >> 2; S.next(i, u); i += 2)       { const int row = tid & 255; const float* p = SSA + (size_t)(u.pm * 256 + row) * 16;
                const f32x4 a = *(const f32x4*)p, b = *(const f32x4*)(p + 4), c = *(const f32x4*)(p + 8), d = *(const f32x4*)(p + 12);
                const float sa = ((a[0] + a[1]) + (a[2] + a[3])) + ((b[0] + b[1]) + (b[2] + b[3])), sb = ((c[0] + c[1]) + (c[2] + c[3])) + ((d[0] + d[1]) + (d[2] + d[3]));
                const float ia = 1.0f / sqrtf(sa * (1.0f / 512.f) + EPS), ib = 1.0f / sqrtf(sb * (1.0f / 512.f) + EPS);
                tab[i * 256 + row] = (f32x2){ia / ib, ib}; } }
            ;
            pg8::Gemm g{(const char*)ATT, Wout_t, D, 256L * D * 2, 128L * D * 2, 256L * D * 2, 128L * D * 2, 0, 0L};
            pg8::EpiRes<true> E{XB, SSX, tab};
            pg8::gemm_phase<pg8::EpiRes<true>, true, false, decltype(pre)>(lds, g, S, E, wave, pre);
        }
        SEAM(pb + 2);

        for (int rep = 0; rep <= ((REP_MASK >> 4) & 1); ++rep) if (IN(pb + 3)) {
            PHASE_IDS;
            pg8::StaticOrder S; S.init(UP_NM, DFF / 128, G, bx, UP_WGM);
            LAS float* tab = (LAS float*)(lds + TAB_OFF);
            { pg8::Unit u; for (int i = wave >> 2; S.next(i, u); i += 2)       { const int row = tid & 255; const int ai = row >> 7, wr = (row >> 6) & 1, m = (row >> 4) & 3, fr = row & 15;
                const int pp = UPM * u.pm - 1 + 126 * wr + 8 * fr + 4 * ai + m;
                const int tok = min(max(pp - (pp > SEQ ? 1 : 0) - (pp > 2 * SEQ + 1 ? 1 : 0), 0), M - 1);
                const float* p = SSX + (size_t)tok * 16;
                const f32x4 a = *(const f32x4*)p, b = *(const f32x4*)(p + 4), c = *(const f32x4*)(p + 8), d = *(const f32x4*)(p + 12);
                const float s = ((a[0] + a[1]) + (a[2] + a[3])) + ((b[0] + b[1]) + (b[2] + b[3])) + ((c[0] + c[1]) + (c[2] + c[3])) + ((d[0] + d[1]) + (d[2] + d[3]));
                tab[i * 256 + row] = (pp >= 0 && pp < MP && pp != SEQ && pp != 2 * SEQ + 1) ? 1.0f / sqrtf(s * (1.0f / D) + EPS) : 0.f; } }
            __syncthreads();
            pg8::Gemm g{(const char*)(XB - D), Wup_t, D, (long)UPM * D * 2, 4L * D * 2, 128L * D * 2, (long)DFF * D * 2, 1, 0L};
            pg8::EpiUp E{HID, (const float*)(ws + WS_CONV) + (size_t)l * 4 * NUP, tab, lds + TAB_OFF + 18 * 1024};
            pg8::gemm_phase<pg8::EpiUp, true, true>(lds, g, S, E, wave);
        }
        SEAM(pb + 3);

        if (IN(pb + 4)) {
            PHASE_IDS;
            pg8::StaticOrder S; S.init(M / 256, D / 256, G, bx, pg8::WGM, 1);
            pg8::Gemm g{(const char*)HID, Wdn_t, DFF, 256L * DFF * 2, 128L * DFF * 2, 256L * DFF * 2, 128L * DFF * 2, 0, 0L};
            if (l == DEPTH - 1 && FUSE_FINAL) {
                pg8::EpiFin E{XB, out, norm_final, (float*)(ws + WS_XSLOT), ctl + CW_CNT, lds + TAB_OFF};
                pg8::gemm_phase<pg8::EpiFin, true, false>(lds, g, S, E, wave);
            } else {
                pg8::EpiRes<false> E{XB, SSX, nullptr};
                pg8::gemm_phase<pg8::EpiRes<false>, true, false>(lds, g, S, E, wave);
            }
        }
        if (!(FUSE_FINAL && l == DEPTH - 1)) SEAM(pb + 4);
    }

    if (!FUSE_FINAL) for (int rep = 0; rep <= ((REP_MASK >> 6) & 1); ++rep) if (IN(N_PHASES - 1)) {
        PHASE_IDS;
        for (int m0 = 4 * gw; m0 < M; m0 += 4 * NGW) {
            u32x4 rw[4][2]; float sv[4];
#pragma unroll
            for (int r = 0; r < 4; ++r) { const int m = m0 + r; const GAS bf16_t* xr = (const GAS bf16_t*)XB + (size_t)(m + m / SEQ) * D;
                sv[r] = ((const GAS float*)SSX)[(size_t)m * 16 + (lane & 15)];
#pragma unroll
                for (int j = 0; j < 2; ++j) rw[r][j] = *(const GAS u32x4*)(xr + 8 * lane + 512 * j); }
            f32x4 g0[2], g1[2];
#pragma unroll
            for (int j = 0; j < 2; ++j) { g0[j] = *(const GAS f32x4*)((const GAS float*)norm_final + 8 * lane + 512 * j); g1[j] = *(const GAS f32x4*)((const GAS float*)norm_final + 8 * lane + 512 * j + 4); }
#pragma unroll
            for (int r = 0; r < 4; ++r) { const int m = m0 + r; float s = sv[r];
                s += __shfl_xor(s, 1); s += __shfl_xor(s, 2); s += __shfl_xor(s, 4); s += __shfl_xor(s, 8);
                const float inv = 1.0f / sqrtf(s * (1.0f / D) + EPS);
                GAS float* orow = (GAS float*)out + (size_t)m * D;
#pragma unroll
                for (int j = 0; j < 2; ++j) { const u32x4 w = rw[r][j];
                    const f32x4 v0 = (f32x4){pg8::bf_lo(w.x), pg8::bf_hi(w.x), pg8::bf_lo(w.y), pg8::bf_hi(w.y)}, v1 = (f32x4){pg8::bf_lo(w.z), pg8::bf_hi(w.z), pg8::bf_lo(w.w), pg8::bf_hi(w.w)};
                    *(GAS f32x4*)(orow + 8 * lane + 512 * j) = v0 * inv * g0[j]; *(GAS f32x4*)(orow + 8 * lane + 512 * j + 4) = v1 * inv * g1[j]; } }
        }
    }
#undef IN
#undef SEAM
}

extern "C" void kernel_launch(void* const* d_in, const int* in_sizes, int n_in, void* d_out, int out_size, void* d_ws, size_t ws_size, hipStream_t stream) {
    static int grid = 0;
    if (grid == 0) {
        if (n_in != 14 || in_sizes[0] != SEQ * D || in_sizes[1] != 2 * SEQ * D || out_size != M * D || ws_size < WS_END) {
            fprintf(stderr, "kernel_launch: unexpected shapes (n_in %d, in0 %d, in1 %d, out %d, ws %zu; need ws >= %zu); nothing launched\n", n_in, n_in > 0 ? in_sizes[0] : -1, n_in > 1 ? in_sizes[1] : -1, out_size, ws_size, (size_t)WS_END);
            grid = -1; return; }
        int dev = 0, cus = 0;
        if (hipGetDevice(&dev) != hipSuccess || hipDeviceGetAttribute(&cus, hipDeviceAttributeMultiprocessorCount, dev) != hipSuccess) { fprintf(stderr, "kernel_launch: device query failed\n"); grid = -1; return; }
        if (hipFuncSetAttribute((const void*)fwd_kernel, hipFuncAttributeMaxDynamicSharedMemorySize, LDS_BYTES) != hipSuccess) { fprintf(stderr, "kernel_launch: hipFuncSetAttribute failed\n"); grid = -1; return; }
        int per_cu = 0;
        if (hipOccupancyMaxActiveBlocksPerMultiprocessor(&per_cu, (const void*)fwd_kernel, NWAVES * 64, LDS_BYTES) != hipSuccess || per_cu < 1)
            fprintf(stderr, "kernel_launch: note: occupancy query reports %d workgroups per CU\n", per_cu);
        (void)hipGetLastError();
        grid = cus;
    }
    if (grid < 0) return;
    if (hipMemsetAsync((char*)d_ws + WS_CTL, 0, CTL_ZERO_BYTES, stream) != hipSuccess) { fprintf(stderr, "kernel_launch: memset failed\n"); return; }
    Args a{};
    for (int i = 0; i < 14; ++i) a.in[i] = (const float*)d_in[i];
    a.out = (float*)d_out; a.ws = (unsigned char*)d_ws;
    if (MK_N_LAUNCHES == 1) {
        a.ph_lo = 0; a.ph_hi = N_PHASES; a.li = 0;
        hipLaunchKernelGGL(fwd_kernel, dim3(grid), dim3(NWAVES * 64), LDS_BYTES, stream, a);
    } else {
        for (int p = 0; p < N_PHASES; ++p) { a.ph_lo = p; a.ph_hi = p + 1; a.li = p; hipLaunchKernelGGL(fwd_kernel, dim3(grid), dim3(NWAVES * 64), LDS_BYTES, stream, a); }
    }
    const hipError_t le = hipPeekAtLastError();
    if (le != hipSuccess) fprintf(stderr, "kernel_launch: launch failed: %s\n", hipGetErrorName(le));
}
```

```cpp
#include <hip/hip_runtime.h>
#include <cstdio>
#include <cstdint>

#ifndef MK_N_LAUNCHES
#define MK_N_LAUNCHES 1
#endif

#ifndef REP_MASK
#define REP_MASK 0
#endif
#define LAS __attribute__((address_space(3)))
#define GAS __attribute__((address_space(1)))
typedef unsigned short bf16_t;
typedef short bf16x8 __attribute__((ext_vector_type(8)));
typedef short s16x4 __attribute__((ext_vector_type(4)));
typedef float f32x2 __attribute__((ext_vector_type(2)));
typedef float f32x4 __attribute__((ext_vector_type(4)));
typedef float f32x16 __attribute__((ext_vector_type(16)));
typedef unsigned u32x2 __attribute__((ext_vector_type(2)));
typedef unsigned u32x4 __attribute__((ext_vector_type(4)));
typedef __bf16 bf16x2_t __attribute__((ext_vector_type(2)));

constexpr int SEQ = 16384, NSEQ = 3, M = NSEQ * SEQ;
constexpr int D = 1024, NIN = 2304, DFF = 2816, NUP = 2 * DFF, DEPTH = 2;
constexpr int COL_QA = 0, COL_KA = 512, COL_VA = 1024, COL_QB = 1536, COL_KB = 2048, COL_VB = 2176;
constexpr float EPS = 1e-6f;
constexpr float LOG2E = 1.4426950408889634f;
constexpr float C2 = 0.125f * LOG2E;
#ifndef UP_WGM
#define UP_WGM 8
#endif
constexpr int UPM = 252;
constexpr int MP = M + NSEQ - 1;
constexpr int UP_NM = (MP + UPM - 1) / UPM;

constexpr size_t MiB = 1u << 20;
constexpr size_t WS_CTL = 0, CTL_ZERO_BYTES = 128 * 1024;
constexpr size_t W_IN_B = (size_t)NIN * D * 2, W_OUT_B = (size_t)D * D * 2, W_UP_B = (size_t)NUP * D * 2, W_DN_B = (size_t)D * DFF * 2;
constexpr size_t WS_W = 1 * MiB, W_LAYER_B = W_IN_B + W_OUT_B + W_UP_B + W_DN_B;
constexpr size_t WS_XB = 48 * MiB + 4096;
constexpr size_t WS_SSX = 146 * MiB, WS_SSA = 149 * MiB;
constexpr size_t WS_PROJ = 152 * MiB;
constexpr size_t WS_ATT = 368 * MiB;
constexpr size_t WS_HID = 152 * MiB;
constexpr size_t WS_END = 464 * MiB;
static_assert(WS_W + DEPTH * W_LAYER_B <= 48 * MiB && WS_XB + (size_t)(MP + 300) * D * 2 <= WS_SSX && WS_SSX + (size_t)M * 64 <= WS_SSA && WS_SSA + (size_t)M * 64 <= WS_PROJ, "ws map");
static_assert(WS_PROJ + (size_t)M * NIN * 2 <= WS_ATT && WS_ATT + (size_t)M * D * 2 <= WS_END && WS_HID + (size_t)M * DFF * 2 <= WS_END, "ws map");
constexpr int CW_BAR = 1024;
constexpr int CW_CNT = 4608;
constexpr size_t WS_CONV = 47 * MiB + 800 * 1024;
constexpr size_t WS_XSLOT = 47 * MiB;
#ifndef FUSE_FINAL
#define FUSE_FINAL 1
#endif

constexpr int RING_BYTES = 131072;
constexpr int MISC_OFF = RING_BYTES;
constexpr int TAB_OFF = RING_BYTES + 1024;
constexpr int TAB_BYTES = 26 * 1024;
constexpr int LDS_BYTES = TAB_OFF + TAB_BYTES;
constexpr int NWAVES = 8;

__device__ __forceinline__ unsigned cvtpk(float lo, float hi) { f32x2 v = {lo, hi}; bf16x2_t b = __builtin_convertvector(v, bf16x2_t); return __builtin_bit_cast(unsigned, b); }
__device__ __forceinline__ float wave_sum(float v) {
#pragma unroll
    for (int o = 1; o < 64; o <<= 1) v += __shfl_xor(v, o);
    return v;
}
__device__ __forceinline__ float dpp_shr1(float x) { return __int_as_float(__builtin_amdgcn_update_dpp(0, __float_as_int(x), 0x111, 0xf, 0xf, true)); }
__device__ __forceinline__ float dpp_shl1(float x) { return __int_as_float(__builtin_amdgcn_update_dpp(0, __float_as_int(x), 0x101, 0xf, 0xf, true)); }
__device__ __forceinline__ float swap_max(float v) { auto rr = __builtin_amdgcn_permlane32_swap(__float_as_uint(v), __float_as_uint(v), false, false); return fmaxf(__uint_as_float(rr[0]), __uint_as_float(rr[1])); }
__device__ __forceinline__ float swap_sum(float v) { auto rr = __builtin_amdgcn_permlane32_swap(__float_as_uint(v), __float_as_uint(v), false, false); return __uint_as_float(rr[0]) + __uint_as_float(rr[1]); }
__device__ __forceinline__ float sum_x16_x32(float v) {
    auto a = __builtin_amdgcn_permlane16_swap(__float_as_uint(v), __float_as_uint(v), false, false); v = __uint_as_float(a[0]) + __uint_as_float(a[1]);
    auto b = __builtin_amdgcn_permlane32_swap(__float_as_uint(v), __float_as_uint(v), false, false); return __uint_as_float(b[0]) + __uint_as_float(b[1]); }
#define LDS_WAIT() asm volatile("s_waitcnt lgkmcnt(0)" ::: "memory")
__device__ __forceinline__ void glds16(const void* gsrc, unsigned lds_dst) { unsigned keep;
    asm volatile("s_mov_b32 %0, m0\n\ts_mov_b32 m0, %2\n\ts_nop 0\n\tglobal_load_lds_dwordx4 %1, off\n\ts_mov_b32 m0, %0" : "=&s"(keep) : "v"(gsrc), "s"(lds_dst) : "memory"); }
__device__ __forceinline__ void glds16s(unsigned voff, const void* sbase, unsigned lds_dst) { unsigned keep;
    asm volatile("s_mov_b32 %0, m0\n\ts_mov_b32 m0, %3\n\ts_nop 0\n\tglobal_load_lds_dwordx4 %1, %2\n\ts_mov_b32 m0, %0" : "=&s"(keep) : "v"(voff), "s"(sbase), "s"(lds_dst) : "memory"); }
__device__ __forceinline__ int lane_now() { int l; asm volatile("v_mbcnt_lo_u32_b32 %0, -1, 0\n\tv_mbcnt_hi_u32_b32 %0, -1, %0" : "=v"(l)); return l; }
__device__ __forceinline__ void glds16s2(unsigned voff0, unsigned voff1, const void* sbase, unsigned lds_dst) {
    asm volatile("s_mov_b32 m0, %3\n\ts_nop 0\n\tglobal_load_lds_dwordx4 %0, %2\n\ts_add_u32 m0, m0, 0x2000\n\ts_nop 0\n\tglobal_load_lds_dwordx4 %1, %2"
                 :: "v"(voff0), "v"(voff1), "s"(sbase), "s"(lds_dst) : "m0", "scc", "memory"); }
__device__ __forceinline__ void glds16kv(unsigned voffk, unsigned voffv, const void* sk, const void* sv, unsigned lds_dst) {
    asm volatile("s_mov_b32 m0, %4\n\ts_nop 0\n\tglobal_load_lds_dwordx4 %0, %2\n\ts_add_u32 m0, m0, 0x2000\n\ts_nop 0\n\tglobal_load_lds_dwordx4 %1, %3"
                 :: "v"(voffk), "v"(voffv), "s"(sk), "s"(sv), "s"(lds_dst) : "m0", "scc", "memory"); }
#define VM_WAIT() asm volatile("s_waitcnt vmcnt(0)" ::: "memory")

namespace pg8 {
constexpr int BM = 256, BK = 64, HALF = 128, HTB = HALF * BK * 2, NXCD = 8, WGM = 8;
__host__ __device__ __forceinline__ int lds_byte(int r, int c) { const int st = (r >> 4) * 2 + (c >> 5), rr = r & 15, cc = c & 31, ob = rr * 64 + cc * 2; return st * 1024 + (ob ^ (((ob >> 9) & 1) << 5)); }
__host__ __device__ __forceinline__ void stage_rc(int b, int& R, int& C) { const int st = b / 1024, sb = b % 1024, swz = sb ^ (((sb >> 9) & 1) << 5); R = (st >> 1) * 16 + swz / 64; C = (st & 1) * 32 + (swz % 64) / 2; }
__host__ __device__ __forceinline__ int perm32(int rho) { const int n = rho >> 4, i = rho & 15; return 8 * (i >> 2) + 4 * n + (i & 3); }

struct Unit { int pm, pn; };
struct Gemm { const char* A; const char* Bt; int K; long a_tstep, a_hstep, b_tstep, b_hstep; int amap; long a_pad; };

struct StaticOrder {
    int nM, nN, nwg, G, c, wgm, rev;
    __device__ void init(int nM_, int nN_, int G_, int c_, int wgm_ = WGM, int rev_ = 0) { nM = nM_; nN = nN_; nwg = nM * nN; G = G_; c = c_; wgm = wgm_; rev = rev_; }
    __device__ bool next(int i, Unit& u) const {
        const long L = (long)i * G + c; if (L >= nwg) return false;
        int wgid = (int)L; { const int q = nwg / NXCD, r = nwg % NXCD, xcd = wgid % NXCD, off = wgid / NXCD; wgid = (xcd < r ? xcd * (q + 1) : r * (q + 1) + (xcd - r) * q) + off; }
        const int nig = wgm * nN, gid = wgid / nig, fm = gid * wgm, gsz = (nM - fm) < wgm ? (nM - fm) : wgm;
        u.pm = fm + ((wgid % nig) % gsz); u.pn = (wgid % nig) / gsz; if (rev) u.pm = nM - 1 - u.pm; return true;
    }
};

struct NoPre { __device__ __forceinline__ void operator()() const {} };
template <class Epi, bool ALIGN_EPI, bool EARLY_DRAIN = true, class Pre = NoPre>
__device__ __forceinline__ void gemm_phase(LAS unsigned char* lds, const Gemm g, const StaticOrder& S, const Epi& E, int wv, const Pre& pre = Pre()) {
    int tid_ = wv * 64 + lane_now(); asm volatile("" : "+v"(tid_));
    const int tid = tid_, wid = __builtin_amdgcn_readfirstlane(tid >> 6), lane = tid & 63, wr = wid >> 2, wc = wid & 3, fr = lane & 15, fq = lane >> 4;
    const int K = g.K, nt = K / BK;
    unsigned voffA[2], voffB[2];
#pragma unroll
    for (int i = 0; i < 2; ++i) { int R, C; stage_rc(tid * 16 + i * 8192, R, C); const int Rb = (R & ~31) + perm32(R & 31);
        const int Ra = g.amap ? (126 * (R >> 6) + 8 * (R & 15) + ((R >> 4) & 3)) : R;
        voffA[i] = (unsigned)(Ra * K + C) * 2u; voffB[i] = (unsigned)(Rb * K + C) * 2u; }
    const size_t kstep = (size_t)(BK * 2);
    const size_t ahs = (size_t)g.a_hstep, bhs = (size_t)g.b_hstep;
    const unsigned ldsw = (unsigned)wid * 1024u; const unsigned ldsn = (unsigned)(uintptr_t)lds + ldsw;
    const int aoff = lds_byte(wr * 64 + fr, fq * 8), boff = lds_byte(wc * 32 + fr, fq * 8);
#define PG8_SA(b, h) (((b) * 2 + (h)) * HTB)
#define PG8_SB(b, h) ((4 + (b) * 2 + (h)) * HTB)
#define PG8_STAGE(bufoff, gbase, voff) glds16s2((voff)[0], (voff)[1], (const void*)(gbase), ldsn + (unsigned)(bufoff))
#define PG8_LDA(dst, b, h) do { _Pragma("unroll") for (int m = 0; m < 4; ++m) _Pragma("unroll") for (int k = 0; k < 2; ++k) dst[m][k] = *(const LAS bf16x8*)(lds + PG8_SA(b, h) + aoff + m * 2048 + k * 1024); } while (0)
#define PG8_LDB(dst, b, h) do { _Pragma("unroll") for (int n = 0; n < 2; ++n) _Pragma("unroll") for (int k = 0; k < 2; ++k) dst[n][k] = *(const LAS bf16x8*)(lds + PG8_SB(b, h) + boff + n * 2048 + k * 1024); } while (0)
#define PG8_MMA(ai, bj, At, Bt) do { __builtin_amdgcn_s_setprio(1); _Pragma("unroll") for (int m = 0; m < 4; ++m) _Pragma("unroll") for (int n = 0; n < 2; ++n) _Pragma("unroll") for (int k = 0; k < 2; ++k) \
        acc[ai][bj][m][n] = __builtin_amdgcn_mfma_f32_16x16x32_bf16(Bt[n][k], At[m][k], acc[ai][bj][m][n], 0, 0, 0); __builtin_amdgcn_s_setprio(0); } while (0)
#define PG8_WAIT_V(n) asm volatile("s_waitcnt vmcnt(" #n ")" ::: "memory")
#define PG8_WAIT_V8_UNLESS(f) asm volatile("s_cmp_lg_u32 %0, 0\n\ts_cbranch_scc1 .Lpg8w%=\n\ts_waitcnt vmcnt(8)\n.Lpg8w%=:" :: "s"(f) : "scc", "memory")
#define PG8_WAIT_L(n) asm volatile("s_waitcnt lgkmcnt(" #n ")" ::: "memory")
#define PG8_BAR __builtin_amdgcn_s_barrier()
#define PG8_SCHED __builtin_amdgcn_sched_barrier(0)
    Unit cur, nxt; int ui = 0; bool fresh = false;
    if (!S.next(0, cur)) return;
    f32x4 acc[2][2][4][2];
#pragma unroll
    for (int a = 0; a < 2; ++a)
#pragma unroll
        for (int b = 0; b < 2; ++b)
#pragma unroll
            for (int m = 0; m < 4; ++m)
#pragma unroll
                for (int n = 0; n < 2; ++n) acc[a][b][m][n] = (f32x4){0.f, 0.f, 0.f, 0.f};
    bf16x8 At[4][2], B0[2][2], B1[2][2];
    const char* cA = g.A + (size_t)cur.pm * g.a_tstep + (size_t)(cur.pm >> 6) * g.a_pad; const char* cB = g.Bt + (size_t)cur.pn * g.b_tstep;
    if constexpr (Epi::HOOK) E.unit_start(cur, ui, wid, lane);
    PG8_STAGE(PG8_SB(0, 0), cB, voffB); PG8_STAGE(PG8_SB(0, 1), cB + bhs, voffB); PG8_STAGE(PG8_SA(0, 0), cA, voffA); PG8_STAGE(PG8_SA(0, 1), cA + ahs, voffA);
    pre();
    if (wr == 1) PG8_BAR;
    PG8_WAIT_V(2); PG8_BAR;
    PG8_STAGE(PG8_SB(1, 0), cB + kstep, voffB); PG8_STAGE(PG8_SA(1, 0), cA + kstep, voffA); PG8_STAGE(PG8_SB(1, 1), cB + bhs + kstep, voffB);
    PG8_WAIT_V(6); PG8_BAR;
    for (;;) {
        const bool has_next = S.next(ui + 1, nxt);
        const char* nA = has_next ? g.A + (size_t)nxt.pm * g.a_tstep + (size_t)(nxt.pm >> 6) * g.a_pad : cA; const char* nB = has_next ? g.Bt + (size_t)nxt.pn * g.b_tstep : cB;
        int landed_flag = fresh ? 1 : 0;
        for (int th = 0; th < nt; th += (Epi::MIDK ? nt / 2 : nt)) {
        if constexpr (Epi::MIDK) { if (th) E.midk(acc, ui, wr, fr); }
        for (int t = th; t < th + (Epi::MIDK ? nt / 2 : nt); t += 2) {
            const bool last = (t == nt - 2);
            const char* a1 = cA + (size_t)(t + 1) * kstep;
            const char* a2 = last ? nA : cA + (size_t)(t + 2) * kstep; const char* b2 = last ? nB : cB + (size_t)(t + 2) * kstep;
            const char* a3 = a2 + kstep; const char* b3 = b2 + kstep;
            int lf_ = EARLY_DRAIN ? __builtin_amdgcn_readfirstlane(landed_flag) : landed_flag; if constexpr (EARLY_DRAIN) asm volatile("" : "+s"(lf_)); landed_flag = 0;
            PG8_LDB(B0, 0, 0); PG8_LDB(B1, 0, 1); PG8_SCHED; PG8_LDA(At, 0, 0); PG8_STAGE(PG8_SA(1, 1), a1 + ahs, voffA);
            if (!lf_) PG8_WAIT_V(8);
            PG8_WAIT_L(0); PG8_BAR; PG8_MMA(0, 0, At, B0); PG8_MMA(0, 1, At, B1); PG8_BAR; PG8_SCHED;
            PG8_LDA(At, 0, 1); PG8_STAGE(PG8_SB(0, 0), b2, voffB); PG8_STAGE(PG8_SB(0, 1), b2 + bhs, voffB); PG8_STAGE(PG8_SA(0, 0), a2, voffA);
            if (!lf_) PG8_WAIT_V(8);
            PG8_WAIT_L(0); PG8_BAR; PG8_MMA(1, 0, At, B0); PG8_MMA(1, 1, At, B1); PG8_BAR; PG8_SCHED;
            PG8_LDB(B0, 1, 0); PG8_LDB(B1, 1, 1); PG8_SCHED; PG8_LDA(At, 1, 0); PG8_STAGE(PG8_SA(0, 1), a2 + ahs, voffA);
            if (!lf_) PG8_WAIT_V(8);
            PG8_WAIT_L(0); PG8_BAR; PG8_MMA(0, 0, At, B0); PG8_MMA(0, 1, At, B1); PG8_BAR; PG8_SCHED;
            PG8_LDA(At, 1, 1); PG8_STAGE(PG8_SB(1, 0), b3, voffB); PG8_STAGE(PG8_SB(1, 1), b3 + bhs, voffB); PG8_STAGE(PG8_SA(1, 0), a3, voffA);
            PG8_WAIT_V(8); PG8_WAIT_L(0); PG8_BAR; PG8_MMA(1, 0, At, B0); PG8_MMA(1, 1, At, B1); PG8_BAR; PG8_SCHED;
        }
        }
        if constexpr (ALIGN_EPI) { if (wr == 0) PG8_BAR; }
        if constexpr (EARLY_DRAIN) {
            PG8_STAGE(PG8_SA(1, 1), nA + kstep + ahs, voffA); if constexpr (!Epi::OWN_DRAIN) PG8_WAIT_V(0);
        }
        { int et_ = lane_now(); asm volatile("" : "+v"(et_)); const int efr = et_ & 15, efq = et_ >> 4;
          E(acc, cur, ui, wr, wc, efr, efq); }
        if (!has_next) break;
#pragma unroll
        for (int a = 0; a < 2; ++a)
#pragma unroll
            for (int b = 0; b < 2; ++b)
#pragma unroll
                for (int m = 0; m < 4; ++m)
#pragma unroll
                    for (int n = 0; n < 2; ++n) acc[a][b][m][n] = (f32x4){0.f, 0.f, 0.f, 0.f};
        cur = nxt; cA = nA; cB = nB; ++ui; fresh = EARLY_DRAIN;
        if constexpr (Epi::HOOK) { int ht_ = lane_now(); asm volatile("" : "+v"(ht_)); E.unit_start(cur, ui, wid, ht_); }
        if constexpr (ALIGN_EPI) { if (wr == 1) PG8_BAR; }
    }
    PG8_WAIT_V(0);
    if constexpr (!ALIGN_EPI) { if (wr == 0) PG8_BAR; }
    PG8_BAR;
#undef PG8_SA
#undef PG8_SB
#undef PG8_STAGE
#undef PG8_LDA
#undef PG8_LDB
#undef PG8_MMA
#undef PG8_WAIT_V
#undef PG8_WAIT_V8_UNLESS
#undef PG8_WAIT_L
#undef PG8_BAR
#undef PG8_SCHED
}

struct EpiProj {
    static constexpr bool MIDK = false, HOOK = false, OWN_DRAIN = false;
    bf16_t* O; const LAS float* rs;
    __device__ __forceinline__ void operator()(const f32x4 (&acc)[2][2][4][2], const Unit& u, int ui, int wr, int wc, int fr, int fq) const {
        const float sct = (u.pn < 2 || u.pn == 6 || u.pn == 7) ? C2 : 1.0f;
        const LAS float* rsu = rs + ui * 256;
#pragma unroll
        for (int ai = 0; ai < 2; ++ai)
#pragma unroll
            for (int m = 0; m < 4; ++m) { const int row = ai * HALF + wr * 64 + m * 16 + fr; const float sc = rsu[row] * sct;
                bf16_t* rowp = O + (size_t)(u.pm * BM + row) * NIN + u.pn * BM + wc * 32 + 8 * fq;
#pragma unroll
                for (int bj = 0; bj < 2; ++bj) { const f32x4 v0 = acc[ai][bj][m][0] * sc, v1 = acc[ai][bj][m][1] * sc;
                    u32x4 w; w.x = cvtpk(v0[0], v0[1]); w.y = cvtpk(v0[2], v0[3]); w.z = cvtpk(v1[0], v1[1]); w.w = cvtpk(v1[2], v1[3]);
                    *(u32x4*)(rowp + bj * HALF) = w; } }
    }
};
__device__ __forceinline__ float bf_lo(unsigned w) { return __uint_as_float(w << 16); }
__device__ __forceinline__ float bf_hi(unsigned w) { return __uint_as_float(w & 0xffff0000u); }
template <bool GRP> struct EpiRes {
    static constexpr bool MIDK = GRP, HOOK = false, OWN_DRAIN = false;
    bf16_t* xb; float* ssx; const LAS f32x2* rs2;
    __device__ __forceinline__ void midk(f32x4 (&acc)[2][2][4][2], int ui, int wr, int fr) const {
        const LAS f32x2* rsu = rs2 + ui * 256;
#pragma unroll
        for (int ai = 0; ai < 2; ++ai)
#pragma unroll
            for (int m = 0; m < 4; ++m) { const float ra = rsu[ai * HALF + wr * 64 + m * 16 + fr].x;
#pragma unroll
                for (int bj = 0; bj < 2; ++bj)
#pragma unroll
                    for (int n = 0; n < 2; ++n) acc[ai][bj][m][n] *= ra; }
    }
    __device__ __forceinline__ void operator()(const f32x4 (&acc)[2][2][4][2], const Unit& u, int ui, int wr, int wc, int fr, int fq) const {
        const int row0 = wr * 64 + fr, col0 = u.pn * BM + wc * 32 + 8 * fq;
        GAS bf16_t* xp0 = (GAS bf16_t*)xb + (size_t)(u.pm * BM + (u.pm >> 6) + row0) * D + col0;
        GAS float* sp = (GAS float*)ssx + (size_t)(u.pm * BM + row0) * 16 + u.pn * 4 + wc;
        const LAS f32x2* rsu = rs2 + ui * 256 + row0;
        u32x4 rw[2][4][2];
#pragma unroll
        for (int ai = 0; ai < 2; ++ai)
#pragma unroll
            for (int m = 0; m < 4; ++m)
#pragma unroll
                for (int bj = 0; bj < 2; ++bj) rw[ai][m][bj] = *(const GAS u32x4*)(xp0 + (size_t)(ai * HALF + m * 16) * D + bj * HALF);
        GAS bf16_t* xp = xp0;
#pragma unroll
        for (int ai = 0; ai < 2; ++ai)
#pragma unroll
            for (int m = 0; m < 4; ++m) {
                float sc = 1.0f; if constexpr (GRP) sc = rsu[ai * HALF + m * 16].y;
                float ss = 0.f;
#pragma unroll
                for (int bj = 0; bj < 2; ++bj) {
                    const u32x4 r = rw[ai][m][bj];
                    const f32x4 r0 = (f32x4){bf_lo(r.x), bf_hi(r.x), bf_lo(r.y), bf_hi(r.y)}, r1 = (f32x4){bf_lo(r.z), bf_hi(r.z), bf_lo(r.w), bf_hi(r.w)};
                    const f32x4 v0 = r0 + acc[ai][bj][m][0] * sc, v1 = r1 + acc[ai][bj][m][1] * sc;
                    u32x4 w; w.x = cvtpk(v0[0], v0[1]); w.y = cvtpk(v0[2], v0[3]); w.z = cvtpk(v1[0], v1[1]); w.w = cvtpk(v1[2], v1[3]);
                    *(GAS u32x4*)(xp + bj * HALF) = w;
                    ss += (v0[0] * v0[0] + v0[1] * v0[1]) + (v0[2] * v0[2] + v0[3] * v0[3]) + (v1[0] * v1[0] + v1[1] * v1[1]) + (v1[2] * v1[2] + v1[3] * v1[3]); }
                ss = sum_x16_x32(ss);
                if (fq == 0) *sp = ss;
                const int adv = (m == 3) ? (HALF - 48) : 16;
                xp += (size_t)adv * D; sp += adv * 16;
                asm volatile("" : "+v"(xp), "+v"(sp)); }
    }
};
struct EpiFin {
    static constexpr bool MIDK = false, HOOK = false, OWN_DRAIN = true;
    const bf16_t* xb; float* out; const float* gfin; float* xslot; unsigned* cnt; LAS unsigned char* scr;
    __device__ __forceinline__ void operator()(f32x4 (&acc)[2][2][4][2], const Unit& u, int ui, int wr, int wc, int fr, int fq) const {
        int tid_ = (wr * 4 + wc) * 64 + lane_now(); asm volatile("" : "+v"(tid_)); const int tid = tid_, lane = tid & 63;
        const int row0 = wr * 64 + fr, col0 = u.pn * BM + wc * 32 + 8 * fq;
        const GAS bf16_t* xp0 = (const GAS bf16_t*)xb + (size_t)(u.pm * BM + (u.pm >> 6) + row0) * D + col0;
        LAS float* P = (LAS float*)scr; LAS float* S = (LAS float*)(scr + 4096); volatile LAS unsigned* flag = (volatile LAS unsigned*)(scr + 5120);
        u32x4 rw[2][4][2];
#pragma unroll
        for (int ai = 0; ai < 2; ++ai)
#pragma unroll
            for (int m = 0; m < 4; ++m)
#pragma unroll
                for (int bj = 0; bj < 2; ++bj) rw[ai][m][bj] = *(const GAS u32x4*)(xp0 + (size_t)(ai * HALF + m * 16) * D + bj * HALF);
#pragma unroll
        for (int ai = 0; ai < 2; ++ai)
#pragma unroll
            for (int m = 0; m < 4; ++m) { float ss = 0.f;
#pragma unroll
                for (int bj = 0; bj < 2; ++bj) { const u32x4 r = rw[ai][m][bj];
                    acc[ai][bj][m][0] += (f32x4){bf_lo(r.x), bf_hi(r.x), bf_lo(r.y), bf_hi(r.y)}; acc[ai][bj][m][1] += (f32x4){bf_lo(r.z), bf_hi(r.z), bf_lo(r.w), bf_hi(r.w)};
                    const f32x4 v0 = acc[ai][bj][m][0], v1 = acc[ai][bj][m][1];
                    ss += (v0[0] * v0[0] + v0[1] * v0[1]) + (v0[2] * v0[2] + v0[3] * v0[3]) + (v1[0] * v1[0] + v1[1] * v1[1]) + (v1[2] * v1[2] + v1[3] * v1[3]); }
                ss = sum_x16_x32(ss);
                if (fq == 0) P[(ai * HALF + row0 + m * 16) * 4 + wc] = ss; }
        asm volatile("s_waitcnt lgkmcnt(0)" ::: "memory"); __builtin_amdgcn_s_barrier(); asm volatile("" ::: "memory");
        GAS float* slot = (GAS float*)xslot + ((size_t)u.pm * 256) * 4;
        if (tid < 256) { const f32x4 p = *(const LAS f32x4*)(P + tid * 4);
            __hip_atomic_store(slot + tid * 4 + u.pn, (p[0] + p[1]) + (p[2] + p[3]), __ATOMIC_RELAXED, __HIP_MEMORY_SCOPE_AGENT); }
        asm volatile("s_waitcnt vmcnt(0)" ::: "memory"); __builtin_amdgcn_s_barrier(); asm volatile("" ::: "memory");
        if (tid == 0) {
            __hip_atomic_fetch_add(cnt + 64 * u.pm, 1u, __ATOMIC_RELAXED, __HIP_MEMORY_SCOPE_AGENT);
            unsigned sp = 0, ok = 1;
            while (__hip_atomic_load(cnt + 64 * u.pm, __ATOMIC_RELAXED, __HIP_MEMORY_SCOPE_AGENT) < 4u) { __builtin_amdgcn_s_sleep(2); if (++sp > (1u << 22)) { ok = 0; break; } }
            __builtin_amdgcn_fence(__ATOMIC_ACQUIRE, "agent");
            flag[0] = ok;
        }
        asm volatile("s_waitcnt vmcnt(0) lgkmcnt(0)" ::: "memory"); __builtin_amdgcn_s_barrier(); asm volatile("" ::: "memory");
        if (tid < 256) { float t = 0.f;
#pragma unroll
            for (int k = 0; k < 4; ++k) t += __hip_atomic_load(slot + tid * 4 + k, __ATOMIC_RELAXED, __HIP_MEMORY_SCOPE_AGENT);
            S[tid] = (flag[0] != 0u) ? 1.0f / sqrtf(t * (1.0f / D) + EPS) : __builtin_nanf(""); }
        asm volatile("s_waitcnt vmcnt(0) lgkmcnt(0)" ::: "memory"); __builtin_amdgcn_s_barrier(); asm volatile("" ::: "memory");
        f32x4 g0[2], g1[2];
#pragma unroll
        for (int bj = 0; bj < 2; ++bj) { g0[bj] = *(const GAS f32x4*)((const GAS float*)gfin + col0 + bj * HALF); g1[bj] = *(const GAS f32x4*)((const GAS float*)gfin + col0 + bj * HALF + 4); }
        GAS float* op = (GAS float*)out + (size_t)(u.pm * BM + row0) * D + col0;
#pragma unroll
        for (int ai = 0; ai < 2; ++ai)
#pragma unroll
            for (int m = 0; m < 4; ++m) { const float iv = S[ai * HALF + row0 + m * 16];
#pragma unroll
                for (int bj = 0; bj < 2; ++bj) { *(GAS f32x4*)(op + bj * HALF) = acc[ai][bj][m][0] * iv * g0[bj]; *(GAS f32x4*)(op + bj * HALF + 4) = acc[ai][bj][m][1] * iv * g1[bj]; }
                const int adv = (m == 3) ? (HALF - 48) : 16; op += (size_t)adv * D; asm volatile("" : "+v"(op)); }
        asm volatile("s_waitcnt lgkmcnt(0)" ::: "memory"); __builtin_amdgcn_s_barrier(); asm volatile("" ::: "memory");
        (void)lane;
    }
};
struct EpiUp {
    static constexpr bool MIDK = false, HOOK = true, OWN_DRAIN = true;
    bf16_t* hid; const float* cws; const LAS float* rs; LAS unsigned char* cbuf;
    __device__ __forceinline__ void unit_start(const Unit& u, int ui, int wid, int lane) const {
        if (wid < 4) { const int a = 2 * wid + (lane >> 5);
            const float* src = cws + (size_t)(a & 3) * NUP + (a >= 4 ? DFF : 0) + u.pn * HALF + (lane & 31) * 4;
            glds16(src, (unsigned)__builtin_amdgcn_readfirstlane((unsigned)(uintptr_t)cbuf + (unsigned)((ui & 1) * 4096 + wid * 1024))); }
    }
    __device__ __forceinline__ void operator()(const f32x4 (&acc)[2][2][4][2], const Unit& u, int ui, int wr, int wc, int fr, int fq) const {
        const LAS float* rsu = rs + ui * 256 + wr * 64 + fr;
        float inv[8];
#pragma unroll
        for (int q = 0; q < 8; ++q) inv[q] = rsu[(q >> 2) * HALF + (q & 3) * 16];
        const int p0 = UPM * u.pm - 1 + 126 * wr + 8 * fr;
        const int cg = u.pn * HALF + wc * 32 + 8 * fq;
#pragma unroll
        for (int h = 0; h < 2; ++h) {
            unsigned pk[2][4][2];
#pragma unroll
            for (int n = 0; n < 2; ++n) {
                const LAS float* wl = (const LAS float*)(cbuf + (ui & 1) * 4096) + wc * 32 + 8 * fq + 4 * n;
#pragma unroll
                for (int ep = 0; ep < 2; ++ep) {
                    const LAS float* wp = wl + 2 * ep;
                    const f32x2 w0g = *(const LAS f32x2*)(wp), w1g = *(const LAS f32x2*)(wp + 128), w2g = *(const LAS f32x2*)(wp + 256), bg = *(const LAS f32x2*)(wp + 384);
                    const f32x2 w0v = *(const LAS f32x2*)(wp + 512), w1v = *(const LAS f32x2*)(wp + 640), w2v = *(const LAS f32x2*)(wp + 768), bv = *(const LAS f32x2*)(wp + 896);
                    float rr[2][4];
#pragma unroll
                    for (int e2 = 0; e2 < 2; ++e2) { const int e = 2 * ep + e2;
                        float xg[6], xv[6];
#pragma unroll
                        for (int i = 1; i < 5; ++i) { xg[i] = acc[h][0][i - 1][n][e] * inv[4 * h + i - 1]; xv[i] = acc[h][1][i - 1][n][e] * inv[4 * h + i - 1]; }
                        if (h == 0) { xg[0] = dpp_shr1(acc[1][0][3][n][e] * inv[7]); xv[0] = dpp_shr1(acc[1][1][3][n][e] * inv[7]); xg[5] = acc[1][0][0][n][e] * inv[4]; xv[5] = acc[1][1][0][n][e] * inv[4]; }
                        else        { xg[0] = acc[0][0][3][n][e] * inv[3]; xv[0] = acc[0][1][3][n][e] * inv[3]; xg[5] = dpp_shl1(acc[0][0][0][n][e] * inv[0]); xv[5] = dpp_shl1(acc[0][1][0][n][e] * inv[0]); }
#pragma unroll
                        for (int i = 1; i < 5; ++i) {
                            const float gc = __builtin_fmaf(w0g[e2], xg[i - 1], __builtin_fmaf(w1g[e2], xg[i], __builtin_fmaf(w2g[e2], xg[i + 1], bg[e2])));
                            const float vc = __builtin_fmaf(w0v[e2], xv[i - 1], __builtin_fmaf(w1v[e2], xv[i], __builtin_fmaf(w2v[e2], xv[i + 1], bv[e2])));
                            const float sg = gc * __builtin_amdgcn_rcpf(1.0f + __builtin_amdgcn_exp2f(gc));
                            rr[e2][i - 1] = sg * vc; }
                    }
#pragma unroll
                    for (int i = 0; i < 4; ++i) pk[n][i][ep] = cvtpk(rr[0][i], rr[1][i]);
                    __builtin_amdgcn_sched_barrier(0);
                }
            }
            if (h == 0) asm volatile("s_waitcnt vmcnt(0)" ::: "memory");
#pragma unroll
            for (int i = 0; i < 4; ++i) { const int q = 4 * h + i; const int j = 8 * fr + q; int p = p0 + q; asm volatile("" : "+v"(p));
                const int tok = p - (p > SEQ ? 1 : 0) - (p > 2 * SEQ + 1 ? 1 : 0);
                if (j >= 1 && j <= 126 && p < MP && p != SEQ && p != 2 * SEQ + 1) { u32x4 w; w.x = pk[0][i][0]; w.y = pk[0][i][1]; w.z = pk[1][i][0]; w.w = pk[1][i][1]; *(GAS u32x4*)((GAS bf16_t*)hid + (size_t)tok * DFF + cg) = w; } }
            __builtin_amdgcn_sched_barrier(0);
        }
    }
};
}

namespace att {
constexpr int PITCH = NIN * 2;
constexpr int SLOT = 16384;
__device__ __forceinline__ float vmax2(float a, float b) { return __builtin_elementwise_maximum(a, b); }
__device__ __forceinline__ float vmax3(float a, float b, float c) { return __builtin_elementwise_maximum(__builtin_elementwise_maximum(a, b), c); }
__device__ __forceinline__ float quad_max3(float m, float v) {
    auto a = __builtin_amdgcn_permlane16_swap(__float_as_uint(v), __float_as_uint(v), false, false); v = vmax2(__uint_as_float(a[0]), __uint_as_float(a[1]));
    auto b = __builtin_amdgcn_permlane32_swap(__float_as_uint(v), __float_as_uint(v), false, false); return vmax3(m, __uint_as_float(b[0]), __uint_as_float(b[1])); }
__device__ __forceinline__ float quad_sum(float v) {
    auto a = __builtin_amdgcn_permlane16_swap(__float_as_uint(v), __float_as_uint(v), false, false); v = __uint_as_float(a[0]) + __uint_as_float(a[1]);
    auto b = __builtin_amdgcn_permlane32_swap(__float_as_uint(v), __float_as_uint(v), false, false); return __uint_as_float(b[0]) + __uint_as_float(b[1]); }
#define WJ(j) ((j) == 0 ? 0 : (j) == 1 ? 8 : (j) == 2 ? 24 : 32)
template <int MODE>
__device__ __forceinline__ void block_unit(LAS unsigned char* ring, const bf16_t* proj, bf16_t* attn, float* ssa, int lane_, int wave,
                                           int ktok0, int nT, int kcol, int vcol, int act0, int actn,
                                           int qtok0, int half, int qcol, const LAS f32x4* bcp, int dr0, float slope2, float sink2, int outcol, int sscol,
                                           int& rbase, const bool pre, const char* nK, const char* nV, const bf16_t* nQ, bf16x8 (&qf)[2][2]) {
    int lane = lane_; asm volatile("" : "+v"(lane));
    const int qi = lane & 15, g = lane >> 4;
    const int rl = lane >> 3, cl = lane & 7;
    const unsigned loffk = (unsigned)((8 * wave + rl) * PITCH + ((cl ^ ((4 * (wave & 1) + (lane >> 4)) & 7)) << 4)), loffv = (unsigned)((8 * wave + rl) * PITCH + ((cl ^ (2 * (lane >> 4))) << 4));
    const char* kg = (const char*)(proj + (size_t)ktok0 * NIN + kcol);
    const char* vg = (const char*)(proj + (size_t)ktok0 * NIN + vcol);
    const unsigned ring0 = (unsigned)(uintptr_t)ring + (unsigned)wave * 1024u;
    const int base = rbase;
#define DMA_TILE(t) do { const unsigned sl_ = (unsigned)__builtin_amdgcn_readfirstlane(ring0 + (unsigned)(((t) + base) % 3) * SLOT); \
        glds16kv(loffk, loffv, kg + (size_t)(t) * 64 * PITCH, vg + (size_t)(t) * 64 * PITCH, sl_); } while (0)
#define DMA_NEXT(i) do { const unsigned sl_ = (unsigned)__builtin_amdgcn_readfirstlane(ring0 + (unsigned)((nT + (i) + base) % 3) * SLOT); \
        glds16kv(loffk, loffv, nK + (size_t)(i) * 64 * PITCH, nV + (size_t)(i) * 64 * PITCH, sl_); } while (0)
    const size_t qoff = (size_t)qi * NIN + 8 * g;
    if (!pre) { DMA_TILE(0); DMA_TILE(1);
#pragma unroll
        for (int jj = 0; jj < 2; ++jj)
#pragma unroll
            for (int ks = 0; ks < 2; ++ks) qf[jj][ks] = *(const GAS bf16x8*)((const GAS bf16_t*)proj + (size_t)(qtok0 + 16 * jj) * NIN + qcol + 32 * ks + qoff);
        __builtin_amdgcn_s_waitcnt(0x0F70);
    } else {
        __builtin_amdgcn_s_waitcnt(0x0F78);
    }
    f32x4 o[2][4];
    float mrun[2], lrun[2];
#pragma unroll
    for (int jj = 0; jj < 2; ++jj) {
#pragma unroll
        for (int dt = 0; dt < 4; ++dt) o[jj][dt] = (f32x4){0.f, 0.f, 0.f, 0.f};
        mrun[jj] = (MODE == 1) ? sink2 : -1e30f; lrun[jj] = (MODE == 1 && g == 0) ? 1.0f : 0.0f; }
    const int va = (lane & 15) >> 2, vb = lane & 3, sv = (2 * (g & 1) + (va >> 1)) & 3;
    int kofs[2], kad[2][2], vad[2], relm[2], bofs[2];
#pragma unroll
    for (int jj = 0; jj < 2; ++jj) {
        const int j = 2 * half + jj; const int koff = (MODE == 1) ? 0 : ((j == 0) ? 0 : (j == 1) ? 8 : (j == 2) ? 24 : 32);
        const int par = (koff >> 3) & 1, s0 = g ^ (qi >> 1);
        kofs[jj] = koff;
        kad[jj][0] = (koff + qi) * 128 + ((s0 ^ (4 * par)) << 4); kad[jj][1] = (koff + qi) * 128 + ((s0 ^ (4 * par) ^ 4) << 4);
        vad[jj] = 8192 + (koff + 4 * g + va) * 128 + vb * 8;
        const int c = 16 * j + qi, cs = min(max(c - 8, 0), 48);
        relm[jj] = koff + 4 * g - cs;
        const int raw = (MODE == 1) ? (ktok0 - (qtok0 + 16 * jj + qi) + 4 * g + 191) : (koff + 4 * g - c + 15 + 16); const int s4 = (3 - qi) & 3;
        bofs[jj] = s4 * ((MODE == 0) ? 968 : 768) + ((raw - s4) >> 2); }
    const float NEG = -INFINITY;
    f32x4 mneg[2][2];
#pragma unroll
    for (int jj = 0; jj < 2; ++jj)
#pragma unroll
        for (int kt = 0; kt < 2; ++kt)
#pragma unroll
            for (int e = 0; e < 4; ++e) mneg[jj][kt][e] = (MODE == 0 && !((unsigned)(relm[jj] + 16 * kt + e) < 16u)) ? NEG : 0.f;
    constexpr int NH = (MODE == 1) ? 2 : 1;
    auto head = [&](const int t) __attribute__((always_inline)) {
        if (t >= 2) { if (t + 1 < nT || nK) asm volatile("s_waitcnt vmcnt(2)" ::: "memory"); else asm volatile("s_waitcnt vmcnt(0)" ::: "memory"); }
        __builtin_amdgcn_s_barrier();
        if (t + 2 < nT) DMA_TILE(t + 2); else if (nK) DMA_NEXT(t + 2 - nT);
    };
    auto body = [&](const int t) __attribute__((always_inline)) {
        if (t >= act0 && t < act0 + actn) {
        const LAS unsigned char* Sl = ring + ((t + base) % 3) * SLOT;
#pragma unroll
        for (int hf = 0; hf < NH; ++hf) {
            if (MODE == 1) { const int ks = ktok0 + 64 * t + 32 * hf;
                if (ks + 31 < qtok0 - 128 || ks > qtok0 + 31 + 128) continue; }
            bf16x8 kf[2][2][2];
#pragma unroll
            for (int jj = 0; jj < 2; ++jj)
#pragma unroll
                for (int kt = 0; kt < 2; ++kt)
#pragma unroll
                    for (int ks = 0; ks < 2; ++ks) kf[jj][kt][ks] = *(const LAS bf16x8*)(Sl + kad[jj][ks] + (32 * hf + 16 * kt) * 128);
            f32x4 bb[2][2];
#pragma unroll
            for (int jj = 0; jj < 2; ++jj) { const LAS f32x4* bl = bcp + ((MODE == 0) ? (dr0 + t - act0) * 8 : 16 * t + 8 * hf) + bofs[jj];
#pragma unroll
                for (int kt = 0; kt < 2; ++kt) bb[jj][kt] = bl[4 * kt]; }
            s16x4 vlo[2][4], vhi[2][4];
#pragma unroll
            for (int jj = 0; jj < 2; ++jj)
#pragma unroll
                for (int dt = 0; dt < 4; ++dt) { const LAS unsigned char* vp = Sl + vad[jj] + (32 * hf) * 128 + ((dt ^ sv) << 5);
                    vlo[jj][dt] = __builtin_bit_cast(s16x4, __builtin_amdgcn_ds_read_tr16_b64_v4i16((LAS s16x4*)(vp)));
                    vhi[jj][dt] = __builtin_bit_cast(s16x4, __builtin_amdgcn_ds_read_tr16_b64_v4i16((LAS s16x4*)(vp + 2048))); }
            __builtin_amdgcn_sched_barrier(0);
            f32x4 s[2][2];
#pragma unroll
            for (int jj = 0; jj < 2; ++jj)
#pragma unroll
                for (int kt = 0; kt < 2; ++kt) { f32x4 a = (MODE == 0) ? bb[jj][kt] + mneg[jj][kt] : bb[jj][kt];
                    a = __builtin_amdgcn_mfma_f32_16x16x32_bf16(kf[jj][kt][0], qf[jj][0], a, 0, 0, 0);
                    s[jj][kt] = __builtin_amdgcn_mfma_f32_16x16x32_bf16(kf[jj][kt][1], qf[jj][1], a, 0, 0, 0); }
            u32x4 pw[2];
#pragma unroll
            for (int jj = 0; jj < 2; ++jj) {
                const float tm = vmax3(vmax3(s[jj][0][0], s[jj][0][1], s[jj][0][2]), vmax3(s[jj][0][3], s[jj][1][0], s[jj][1][1]), vmax3(s[jj][1][2], s[jj][1][3], s[jj][1][3]));
                const float mn = quad_max3(mrun[jj], tm);
                const float alpha = __builtin_amdgcn_exp2f(mrun[jj] - mn);
                mrun[jj] = mn;
                float rsum = 0.f;
#pragma unroll
                for (int kt = 0; kt < 2; ++kt)
#pragma unroll
                    for (int e = 0; e < 4; ++e) { s[jj][kt][e] = __builtin_amdgcn_exp2f(s[jj][kt][e] - mn); rsum += s[jj][kt][e]; }
                lrun[jj] = lrun[jj] * alpha + rsum;
#pragma unroll
                for (int dt = 0; dt < 4; ++dt) o[jj][dt] *= alpha;
                pw[jj].x = cvtpk(s[jj][0][0], s[jj][0][1]); pw[jj].y = cvtpk(s[jj][0][2], s[jj][0][3]); pw[jj].z = cvtpk(s[jj][1][0], s[jj][1][1]); pw[jj].w = cvtpk(s[jj][1][2], s[jj][1][3]);
            }
#pragma unroll
            for (int jj = 0; jj < 2; ++jj)
#pragma unroll
                for (int dt = 0; dt < 4; ++dt) {
                    const bf16x8 vf = (bf16x8){vlo[jj][dt][0], vlo[jj][dt][1], vlo[jj][dt][2], vlo[jj][dt][3], vhi[jj][dt][0], vhi[jj][dt][1], vhi[jj][dt][2], vhi[jj][dt][3]};
                    o[jj][dt] = __builtin_amdgcn_mfma_f32_16x16x32_bf16(vf, __builtin_bit_cast(bf16x8, pw[jj]), o[jj][dt], 0, 0, 0); }
            __builtin_amdgcn_sched_barrier(0);
        }
        }
    };
    for (int t = 0; t < nT - 1; ++t) { head(t); body(t); }
    head(nT - 1);
    bf16x8 qn[2][2];
    { const GAS bf16_t* qs = nQ ? (const GAS bf16_t*)nQ : (const GAS bf16_t*)proj + (size_t)qtok0 * NIN + qcol;
#pragma unroll
      for (int jj = 0; jj < 2; ++jj)
#pragma unroll
          for (int ks = 0; ks < 2; ++ks) qn[jj][ks] = *(const GAS bf16x8*)(qs + (size_t)(16 * jj) * NIN + 32 * ks + qoff); }
    body(nT - 1);
#undef DMA_TILE
#undef DMA_NEXT
    rbase = (base + nT) % 3;
    {
#pragma unroll
    for (int jj = 0; jj < 2; ++jj) {
        const float lt = quad_sum(lrun[jj]); const float il = 1.0f / lt;
        const int tok = qtok0 + 16 * jj + qi;
        float ss = 0.f;
#pragma unroll
        for (int dt = 0; dt < 4; ++dt) { const f32x4 v = o[jj][dt] * il;
            ss += (v[0] * v[0] + v[1] * v[1]) + (v[2] * v[2] + v[3] * v[3]);
            u32x2 w; w.x = cvtpk(v[0], v[1]); w.y = cvtpk(v[2], v[3]);
            *(GAS u32x2*)((GAS bf16_t*)attn + (size_t)tok * D + outcol + 16 * dt + 4 * g) = w; }
        ss = quad_sum(ss);
        if (g == 0) ((GAS float*)ssa)[(size_t)tok * 16 + sscol] = ss;
    }
    }
#pragma unroll
    for (int jj = 0; jj < 2; ++jj)
#pragma unroll
        for (int ks = 0; ks < 2; ++ks) { qf[jj][ks] = qn[jj][ks]; asm volatile("" : "+v"(qf[jj][ks])); }
    __builtin_amdgcn_s_barrier();
}
#undef WJ
}

#define XB_TMO      128
#define XB_XCNT(j)  (256  + 64 * (j))
#define XB_XSUB(j)  (1280 + 64 * (j))
#define XB_XGEN(j)  (2304 + 64 * (j))
#define XB_TOP      3328
#define XB_TOPGEN   3392
#define XCD_BAR_WORDS 3456
#define XB_SPIN_CAP (1u << 20)
__device__ __forceinline__ unsigned xb_ld(unsigned* p)              { return __hip_atomic_load(p, __ATOMIC_RELAXED, __HIP_MEMORY_SCOPE_AGENT); }
__device__ __forceinline__ unsigned xb_add(unsigned* p, unsigned v) { return __hip_atomic_fetch_add(p, v, __ATOMIC_RELAXED, __HIP_MEMORY_SCOPE_AGENT); }
__device__ __forceinline__ unsigned xb_xcc_id() { return (unsigned)__builtin_amdgcn_s_getreg((3 << 11) | 20) & 0xFu; }
#define XB_SPIN(cond, bar) do { unsigned _sp = 0; while (cond) { __builtin_amdgcn_s_sleep(1); \
    if ((++_sp & 255u) == 0u) { if (xb_ld(&(bar)[XB_TMO])) break; if (_sp > XB_SPIN_CAP) { atomicAdd(&(bar)[XB_TMO], 1u); break; } } } } while (0)
struct XcdBarrier { unsigned* bar; unsigned x; volatile LAS unsigned* st; };
__device__ __forceinline__ XcdBarrier xcd_barrier_post(unsigned* bar, volatile LAS unsigned* st) {
    XcdBarrier b; b.bar = bar; b.x = xb_xcc_id(); b.st = st;
    if (threadIdx.x == 0) (void)xb_add(&bar[XB_XCNT(b.x)], 1u);
    return b;
}
__device__ __forceinline__ void xcd_barrier_complete(unsigned* bar, unsigned x, unsigned& nloc, unsigned& nx) {
    const unsigned G = gridDim.x * gridDim.y * gridDim.z;
    unsigned sum, cnt, mine, sp = 0u;
    for (;;) {
        sum = 0u; cnt = 0u; mine = 0u;
#pragma unroll
        for (unsigned j = 0; j < 16; ++j) { const unsigned c = xb_ld(&bar[XB_XCNT(j)]); sum += c; cnt += (c > 0u) ? 1u : 0u; mine = (j == x) ? c : mine; }
        if (sum == G) break;
        __builtin_amdgcn_s_sleep(1);
        if ((++sp & 255u) == 0u) { if (xb_ld(&bar[XB_TMO])) break; if (sp > XB_SPIN_CAP) { atomicAdd(&bar[XB_TMO], 1u); break; } }
    }
    nloc = mine > 0u ? mine : 1u; nx = cnt > 0u ? cnt : 1u;
}
__device__ __forceinline__ void xcd_barrier(const XcdBarrier& b, int wv) {
    asm volatile("s_waitcnt vmcnt(0)" ::: "memory");
    __syncthreads();
    if (wv == 0 && lane_now() == 0) {
        unsigned* bar = b.bar;
        __builtin_amdgcn_s_waitcnt(0);
        unsigned nloc = b.st[0], nx = b.st[1];
        if (nloc == 0u) { xcd_barrier_complete(bar, b.x, nloc, nx); b.st[0] = nloc; b.st[1] = nx; }
        const unsigned old = xb_add(&bar[XB_XSUB(b.x)], 1u);
        const unsigned gen = old / nloc;
        if (old + 1u == (gen + 1u) * nloc) {
            __builtin_amdgcn_fence(__ATOMIC_RELEASE, "agent");
            asm volatile("s_waitcnt vmcnt(0)" ::: "memory");
            const unsigned og = xb_add(&bar[XB_TOP], 1u);
            const unsigned tg = og / nx;
            if (og + 1u == (tg + 1u) * nx) xb_add(&bar[XB_TOPGEN], 1u);
            else XB_SPIN(xb_ld(&bar[XB_TOPGEN]) == tg, bar);
            __builtin_amdgcn_fence(__ATOMIC_ACQUIRE, "agent");
            xb_add(&bar[XB_XGEN(b.x)], 1u);
            asm volatile("s_waitcnt vmcnt(0)" ::: "memory");
        } else {
            XB_SPIN(xb_ld(&bar[XB_XGEN(b.x)]) == gen, bar);
            __builtin_amdgcn_fence(__ATOMIC_ACQUIRE, "agent");
            asm volatile("s_waitcnt vmcnt(0)" ::: "memory");
        }
    }
    __syncthreads();
}

struct Args { const float* in[14]; float* out; unsigned char* ws; int ph_lo, ph_hi, li, pad; };
constexpr int N_PHASES = 2 + 5 * DEPTH;

__device__ __forceinline__ void transpose_item(const float* W, const float* gain, int K, int N, bf16_t* WT, LAS float* scr, int item, int lane) {
    const int nblk = N / 32, kb = item / nblk, nb = item % nblk, k0 = 64 * kb, n0 = 32 * nb;
    f32x4 wv[8]; float gk[8];
#pragma unroll
    for (int i = 0; i < 8; ++i) { const int kk = (lane >> 3) + 8 * i; wv[i] = *(const GAS f32x4*)((const GAS float*)W + (size_t)(k0 + kk) * N + n0 + 4 * (lane & 7)); gk[i] = gain ? gain[k0 + kk] : 1.0f; }
#pragma unroll
    for (int i = 0; i < 8; ++i) { const int kk = (lane >> 3) + 8 * i; LAS float* d = scr + kk * 33 + 4 * (lane & 7);
        d[0] = wv[i][0] * gk[i]; d[1] = wv[i][1] * gk[i]; d[2] = wv[i][2] * gk[i]; d[3] = wv[i][3] * gk[i]; }
    LDS_WAIT(); asm volatile("" ::: "memory");
    const int c = lane & 7;
#pragma unroll
    for (int j = 0; j < 4; ++j) { const int n = (lane >> 3) + 8 * j; const LAS float* s = scr + (8 * c) * 33 + n;
        u32x4 o; o.x = cvtpk(s[0 * 33], s[1 * 33]); o.y = cvtpk(s[2 * 33], s[3 * 33]); o.z = cvtpk(s[4 * 33], s[5 * 33]); o.w = cvtpk(s[6 * 33], s[7 * 33]);
        *(u32x4*)(WT + (size_t)(n0 + n) * K + k0 + 8 * c) = o; }
    LDS_WAIT(); asm volatile("" ::: "memory");
}

__global__ void __launch_bounds__(NWAVES * 64, 2) fwd_kernel(Args args) {
    extern __shared__ __attribute__((aligned(16))) unsigned char lds_raw[];
    LAS unsigned char* lds = (LAS unsigned char*)lds_raw;
    volatile LAS unsigned* MISC = (volatile LAS unsigned*)(lds + MISC_OFF);
    const int G = gridDim.x; const int bx = blockIdx.x; const int vcu = (G % 8 == 0) ? (bx % 8) * (G / 8) + bx / 8 : bx;
    unsigned char* ws = args.ws;
    unsigned* ctl = (unsigned*)(ws + WS_CTL);
    const float* x_p = args.in[0]; const float* x_s = args.in[1];
    const float* norm_mix = args.in[2]; const float* w_in = args.in[3]; const float* rpb = args.in[4]; const float* sinks = args.in[5];
    const float* norm_grp = args.in[6]; const float* w_out = args.in[7]; const float* norm_ffn = args.in[8]; const float* w_up = args.in[9];
    const float* conv_w = args.in[10]; const float* conv_b = args.in[11]; const float* w_down = args.in[12]; const float* norm_final = args.in[13];
    float* out = args.out;
    bf16_t* XB = (bf16_t*)(ws + WS_XB); float* SSX = (float*)(ws + WS_SSX); float* SSA = (float*)(ws + WS_SSA);
    bf16_t* PROJ = (bf16_t*)(ws + WS_PROJ); bf16_t* ATT = (bf16_t*)(ws + WS_ATT); bf16_t* HID = (bf16_t*)(ws + WS_HID);

    const int wave_s = __builtin_amdgcn_readfirstlane((int)(threadIdx.x >> 6));
    for (int u = threadIdx.x; u < 256; u += NWAVES * 64) ((LAS unsigned*)(lds + MISC_OFF))[u] = 0u;
    __syncthreads();
    XcdBarrier bar; bar.bar = ctl + CW_BAR; bar.x = 0; bar.st = nullptr;
    if (MK_N_LAUNCHES == 1) bar = xcd_barrier_post(ctl + CW_BAR, MISC + 8);
    const int lo = args.ph_lo, hi_ph = args.ph_hi;
#define PHASE_IDS int tid_ = wave_s * 64 + lane_now(); asm volatile("" : "+v"(tid_) :: "memory"); const int tid = tid_, lane = tid & 63, wave = wave_s; const int gw = vcu * NWAVES + wave, NGW = G * NWAVES; (void)lane; (void)gw; (void)NGW
#ifndef PH_MASK
#define PH_MASK 0x7f
#endif
#define KIND(k) ((k) == 0 ? 0 : ((k) == N_PHASES - 1 ? 6 : 1 + ((k) - 1) % 5))
#define IN(k) (((PH_MASK >> KIND(k)) & 1) && lo <= (k) && (k) < hi_ph)
#define SEAM(k) do { if (IN(k) && IN((k) + 1)) xcd_barrier(bar, wave_s); } while (0)

    for (int rep = 0; rep <= ((REP_MASK >> 0) & 1); ++rep) if (IN(0)) {
        PHASE_IDS;
        LAS float* scr = (LAS float*)(lds + wave * 16384);
        constexpr int I_IN = (D / 64) * (NIN / 32), I_OUT = (D / 64) * (D / 32), I_UP = (D / 64) * (NUP / 32), I_DN = (DFF / 64) * (D / 32), I_L = I_IN + I_OUT + I_UP + I_DN;
        for (int it = gw; it < DEPTH * I_L; it += NGW) {
            const int l = it / I_L; int r = it % I_L;
            unsigned char* wl = ws + WS_W + (size_t)l * W_LAYER_B;
            if (r < I_IN) { transpose_item(w_in + (size_t)l * D * NIN, norm_mix + l * D, D, NIN, (bf16_t*)wl, scr, r, lane); continue; } r -= I_IN;
            if (r < I_OUT) { transpose_item(w_out + (size_t)l * D * D, norm_grp + l * D, D, D, (bf16_t*)(wl + W_IN_B), scr, r, lane); continue; } r -= I_OUT;
            if (r < I_UP) { transpose_item(w_up + (size_t)l * D * NUP, norm_ffn + l * D, D, NUP, (bf16_t*)(wl + W_IN_B + W_OUT_B), scr, r, lane); continue; } r -= I_UP;
            transpose_item(w_down + (size_t)l * DFF * D, nullptr, DFF, D, (bf16_t*)(wl + W_IN_B + W_OUT_B + W_UP_B), scr, r, lane);
        }
        for (int m0 = 4 * gw; m0 < M; m0 += 4 * NGW) {
            f32x4 v[4][4];
#pragma unroll
            for (int r = 0; r < 4; ++r) { const int m = m0 + r; const GAS float* xr = (m < SEQ) ? (const GAS float*)x_p + (size_t)m * D : (const GAS float*)x_s + (size_t)(m - SEQ) * D;
#pragma unroll
                for (int j = 0; j < 4; ++j) v[r][j] = *(const GAS f32x4*)(xr + 4 * lane + 256 * j); }
#pragma unroll
            for (int r = 0; r < 4; ++r) { const int m = m0 + r; float s = 0.f;
#pragma unroll
                for (int j = 0; j < 4; ++j) s += (v[r][j][0] * v[r][j][0] + v[r][j][1] * v[r][j][1]) + (v[r][j][2] * v[r][j][2] + v[r][j][3] * v[r][j][3]);
                s = wave_sum(s);
#pragma unroll
                for (int j = 0; j < 4; ++j) { u32x2 w; w.x = cvtpk(v[r][j][0], v[r][j][1]); w.y = cvtpk(v[r][j][2], v[r][j][3]); *(GAS u32x2*)((GAS bf16_t*)XB + (size_t)(m + m / SEQ) * D + 4 * lane + 256 * j) = w; }
                if (lane < 16) ((GAS float*)SSX)[(size_t)m * 16 + lane] = s * (1.0f / 16.0f); }
        }
        for (int i = gw * 64 + lane; i < DEPTH * 4 * NUP; i += NGW * 64) {
            const int c = i % NUP, a = (i / NUP) & 3, l2 = i / (4 * NUP);
            const float v = (a < 3) ? conv_w[((size_t)l2 * 3 + a) * NUP + c] : conv_b[(size_t)l2 * NUP + c];
            ((float*)(ws + WS_CONV))[i] = v * ((c < DFF) ? -LOG2E : -1.0f / LOG2E); }
        for (int z = gw; z < 3 + 300; z += NGW) {
            const long prow = (z == 0) ? -1 : (z == 1) ? SEQ : (z == 2) ? 2 * SEQ + 1 : (long)MP + (z - 3);
#pragma unroll
            for (int j = 0; j < 4; ++j) *(u32x2*)(XB + prow * D + 4 * lane + 256 * j) = (u32x2){0u, 0u};
        }
    }
    SEAM(0);

    for (int l = 0; l < DEPTH; ++l) {
        const int pb = 1 + 5 * l;
        const unsigned char* wl = ws + WS_W + (size_t)l * W_LAYER_B;
        const char* Win_t = (const char*)wl; const char* Wout_t = (const char*)(wl + W_IN_B); const char* Wup_t = (const char*)(wl + W_IN_B + W_OUT_B); const char* Wdn_t = (const char*)(wl + W_IN_B + W_OUT_B + W_UP_B);

        for (int rep = 0; rep <= ((REP_MASK >> 1) & 1); ++rep) if (IN(pb)) {
            PHASE_IDS;
            pg8::StaticOrder S; S.init(M / 256, NIN / 256, G, bx);
            LAS float* tab = (LAS float*)(lds + TAB_OFF);
            auto pre = [&]() __attribute__((always_inline))
            { pg8::Unit u; for (int i = wave >> 2; S.next(i, u); i += 2)       { const int row = tid & 255; const float* p = SSX + (size_t)(u.pm * 256 + row) * 16;
                const f32x4 a = *(const f32x4*)p, b = *(const f32x4*)(p + 4), c = *(const f32x4*)(p + 8), d = *(const f32x4*)(p + 12);
                const float s = ((a[0] + a[1]) + (a[2] + a[3])) + ((b[0] + b[1]) + (b[2] + b[3])) + ((c[0] + c[1]) + (c[2] + c[3])) + ((d[0] + d[1]) + (d[2] + d[3]));
                tab[i * 256 + row] = 1.0f / sqrtf(s * (1.0f / D) + EPS); } }
            ;
            pg8::Gemm g{(const char*)XB, Win_t, D, 256L * D * 2, 128L * D * 2, 256L * D * 2, 128L * D * 2, 0, (long)D * 2};
            pg8::EpiProj E{PROJ, tab};
            pg8::gemm_phase<pg8::EpiProj, true, true, decltype(pre)>(lds, g, S, E, wave, pre);
        }
        SEAM(pb);

        for (int rep = 0; rep <= ((REP_MASK >> 2) & 1); ++rep) if (IN(pb + 1)) {
            PHASE_IDS;
            LAS float* tab = (LAS float*)(lds + TAB_OFF);
            for (int i = tid; i < 8 * 15 * 32; i += NWAVES * 64) { const int h = i / 480, rem = i % 480, dr = rem >> 5, o = rem & 31;
                tab[i] = (o < 31) ? rpb[((size_t)(l * 8 + h) * 15 + dr) * 31 + o] * LOG2E : 0.f; }
            if (tid < 16) tab[8 * 15 * 32 + tid] = 0.f;
            __syncthreads();
            LAS f32x4* cpy = (LAS f32x4*)(lds + 65536);
            for (int i = tid; i < 4 * 968; i += NWAVES * 64) { const int sft = i / 968, k = i % 968; f32x4 v;
#pragma unroll
                for (int e = 0; e < 4; ++e) { const int x = 4 * k + sft + e - 16; v[e] = (x >= 0 && x < 8 * 15 * 32 + 16) ? tab[min(max(x, 0), 8 * 15 * 32 + 15)] : 0.f; }
                cpy[i] = v; }
            __syncthreads();
            int rbase = 0; bool pre = false; bf16x8 qf[2][2] = {};
            auto kbase_n = [&](int n, const char*& K0, const char*& V0) __attribute__((always_inline)) { const int r4 = n & 63, h = (n >> 6) & 7, sq = n >> 9; const int rs0 = min(max(4 * r4 - 4, 0), 248);
                const bf16_t* b = PROJ + (size_t)(sq * SEQ + rs0 * 64) * NIN; K0 = (const char*)(b + COL_KA + h * 64); V0 = (const char*)(b + COL_VA + h * 64); };
            auto kbase_s = [&](int n, const char*& K0, const char*& V0) __attribute__((always_inline)) { const int tt = n & 255, kvh = (n >> 8) & 1, sq = n >> 9; const int u_lo = max(64 * tt - 128, 0);
                const bf16_t* b = PROJ + (size_t)(sq * SEQ + u_lo) * NIN; K0 = (const char*)(b + COL_KB + kvh * 64); V0 = (const char*)(b + COL_VB + kvh * 64); };
            for (int rp = 0; rp <= ((REP_MASK >> 8) & 1); ++rp)
            for (int n = vcu; n < 1536; n += G) {
                const int r4 = n & 63, h = (n >> 6) & 7, sq = n >> 9; const int r0 = 4 * r4, r = r0 + (wave >> 1);
                const int rs0 = min(max(r0 - 4, 0), 248), rs3 = min(max(r0 - 1, 0), 248), rs = min(max(r - 4, 0), 248);
                const char* nK = nullptr; const char* nV = nullptr;
                const bf16_t* nQ = nullptr;
                if (n + G < 1536) { kbase_n(n + G, nK, nV); const int n2 = n + G; nQ = PROJ + (size_t)((n2 >> 9) * SEQ + (4 * (n2 & 63) + (wave >> 1)) * 64 + 32 * (wave & 1)) * NIN + COL_QA + ((n2 >> 6) & 7) * 64; }
                else if (REP_MASK == 0 && vcu < 1536) { kbase_s(vcu, nK, nV); const int n2 = vcu; nQ = PROJ + (size_t)((n2 >> 9) * SEQ + 64 * (n2 & 255) + 32 * (wave >> 2)) * NIN + COL_QB + (4 * ((n2 >> 8) & 1) + (wave & 3)) * 64; }
                att::block_unit<0>(lds, PROJ, ATT, SSA, lane, wave, sq * SEQ + rs0 * 64, rs3 + 8 - rs0, COL_KA + h * 64, COL_VA + h * 64, rs - rs0, 8,
                                   sq * SEQ + r * 64 + 32 * (wave & 1), wave & 1, COL_QA + h * 64, cpy + h * 120, rs - r + 7, 0.f, 0.f, h * 64, h, rbase, pre, nK, nV, nQ, qf);
                pre = (nK != nullptr);
            }
            __syncthreads();
            for (int i = tid; i < 8 * 384; i += NWAVES * 64) { const int h = i / 384, dd = abs(i % 384 - 191);
                tab[i] = (dd <= 128) ? -__builtin_amdgcn_exp2f(-(float)(h + 1)) * LOG2E * (float)dd : -INFINITY; }
            __syncthreads();
            for (int i = tid; i < 4 * 768; i += NWAVES * 64) { const int sft = i / 768, k = i % 768; f32x4 v;
#pragma unroll
                for (int e = 0; e < 4; ++e) { const int x = 4 * k + sft + e; v[e] = (x < 8 * 384) ? tab[min(x, 8 * 384 - 1)] : -INFINITY; }
                cpy[i] = v; }
            __syncthreads();
            float sinkA = sinks[l * 8 + (wave & 3)] * LOG2E, sinkB = sinks[l * 8 + 4 + (wave & 3)] * LOG2E;
            __builtin_amdgcn_s_waitcnt(0x0F70); asm volatile("" : "+v"(sinkA), "+v"(sinkB));
            for (int rp = 0; rp <= ((REP_MASK >> 9) & 1); ++rp)
            for (int n = vcu; n < 1536; n += G) {
                const int tt = n & 255, kvh = (n >> 8) & 1, sq = n >> 9; const int hb = 4 * kvh + (wave & 3), t0 = 64 * tt;
                const int u_lo = max(t0 - 128, 0), u_hi = min(t0 + 192, SEQ);
                const float slope2 = __builtin_amdgcn_exp2f(-(float)(hb + 1)) * LOG2E; const float sink2 = kvh ? sinkB : sinkA;
                const char* nK = nullptr; const char* nV = nullptr;
                const bf16_t* nQ = nullptr;
                if (n + G < 1536) { kbase_s(n + G, nK, nV); const int n2 = n + G; nQ = PROJ + (size_t)((n2 >> 9) * SEQ + 64 * (n2 & 255) + 32 * (wave >> 2)) * NIN + COL_QB + (4 * ((n2 >> 8) & 1) + (wave & 3)) * 64; }
                att::block_unit<1>(lds, PROJ, ATT, SSA, lane, wave, sq * SEQ + u_lo, (u_hi - u_lo) >> 6, COL_KB + kvh * 64, COL_VB + kvh * 64, 0, (u_hi - u_lo) >> 6,
                                   sq * SEQ + t0 + 32 * (wave >> 2), wave >> 2, COL_QB + hb * 64, cpy + hb * 96, 0, slope2, sink2, 512 + hb * 64, 8 + hb, rbase, pre, nK, nV, nQ, qf);
                pre = (nK != nullptr);
            }
            __syncthreads();
        }
        SEAM(pb + 1);

        if (IN(pb + 2)) {
            PHASE_IDS;
            pg8::StaticOrder S; S.init(M / 256, D / 256, G, bx);
            LAS f32x2* tab = (LAS f32x2*)(lds + TAB_OFF);
            auto pre = [&]() __attribute__((always_inline))
            { pg8::Unit u; for (int i = wave >> 2; S.next(i, u); i += 2)       { const int row = tid & 255; const float* p = SSA + (size_t)(u.pm * 256 + row) * 16;
                const f32x4 a = *(const f32x4*)p, b = *(const f32x4*)(p + 4), c = *(const f32x4*)(p + 8), d = *(const f32x4*)(p + 12);
                const float sa = ((a[0] + a[1]) + (a[2] + a[3])) + ((b[0] + b[1]) + (b[2] + b[3])), sb = ((c[0] + c[1]) + (c[2] + c[3])) + ((d[0] + d[1]) + (d[2] + d[3]));
                const float ia = 1.0f / sqrtf(sa * (1.0f / 512.f) + EPS), ib = 1.0f / sqrtf(sb * (1.0f / 512.f) + EPS);
                tab[i * 256 + row] = (f32x2){ia / ib, ib}; } }
            ;
            pg8::Gemm g{(const char*)ATT, Wout_t, D, 256L * D * 2, 128L * D * 2, 256L * D * 2, 128L * D * 2, 0, 0L};
            pg8::EpiRes<true> E{XB, SSX, tab};
            pg8::gemm_phase<pg8::EpiRes<true>, true, false, decltype(pre)>(lds, g, S, E, wave, pre);
        }
        SEAM(pb + 2);

        for (int rep = 0; rep <= ((REP_MASK >> 4) & 1); ++rep) if (IN(pb + 3)) {
            PHASE_IDS;
            pg8::StaticOrder S; S.init(UP_NM, DFF / 128, G, bx, UP_WGM);
            LAS float* tab = (LAS float*)(lds + TAB_OFF);
            { pg8::Unit u; for (int i = wave >> 2; S.next(i, u); i += 2)       { const int row = tid & 255; const int ai = row >> 7, wr = (row >> 6) & 1, m = (row >> 4) & 3, fr = row & 15;
                const int pp = UPM * u.pm - 1 + 126 * wr + 8 * fr + 4 * ai + m;
                const int tok = min(max(pp - (pp > SEQ ? 1 : 0) - (pp > 2 * SEQ + 1 ? 1 : 0), 0), M - 1);
                const float* p = SSX + (size_t)tok * 16;
                const f32x4 a = *(const f32x4*)p, b = *(const f32x4*)(p + 4), c = *(const f32x4*)(p + 8), d = *(const f32x4*)(p + 12);
                const float s = ((a[0] + a[1]) + (a[2] + a[3])) + ((b[0] + b[1]) + (b[2] + b[3])) + ((c[0] + c[1]) + (c[2] + c[3])) + ((d[0] + d[1]) + (d[2] + d[3]));
                tab[i * 256 + row] = (pp >= 0 && pp < MP && pp != SEQ && pp != 2 * SEQ + 1) ? 1.0f / sqrtf(s * (1.0f / D) + EPS) : 0.f; } }
            __syncthreads();
            pg8::Gemm g{(const char*)(XB - D), Wup_t, D, (long)UPM * D * 2, 4L * D * 2, 128L * D * 2, (long)DFF * D * 2, 1, 0L};
            pg8::EpiUp E{HID, (const float*)(ws + WS_CONV) + (size_t)l * 4 * NUP, tab, lds + TAB_OFF + 18 * 1024};
            pg8::gemm_phase<pg8::EpiUp, true, true>(lds, g, S, E, wave);
        }
        SEAM(pb + 3);

        if (IN(pb + 4)) {
            PHASE_IDS;
            pg8::StaticOrder S; S.init(M / 256, D / 256, G, bx, pg8::WGM, 1);
            pg8::Gemm g{(const char*)HID, Wdn_t, DFF, 256L * DFF * 2, 128L * DFF * 2, 256L * DFF * 2, 128L * DFF * 2, 0, 0L};
            if (l == DEPTH - 1 && FUSE_FINAL) {
                pg8::EpiFin E{XB, out, norm_final, (float*)(ws + WS_XSLOT), ctl + CW_CNT, lds + TAB_OFF};
                pg8::gemm_phase<pg8::EpiFin, true, true>(lds, g, S, E, wave);
            } else {
                pg8::EpiRes<false> E{XB, SSX, nullptr};
                pg8::gemm_phase<pg8::EpiRes<false>, true, false>(lds, g, S, E, wave);
            }
        }
        if (!(FUSE_FINAL && l == DEPTH - 1)) SEAM(pb + 4);
    }

    if (!FUSE_FINAL) for (int rep = 0; rep <= ((REP_MASK >> 6) & 1); ++rep) if (IN(N_PHASES - 1)) {
        PHASE_IDS;
        for (int m0 = 4 * gw; m0 < M; m0 += 4 * NGW) {
            u32x4 rw[4][2]; float sv[4];
#pragma unroll
            for (int r = 0; r < 4; ++r) { const int m = m0 + r; const GAS bf16_t* xr = (const GAS bf16_t*)XB + (size_t)(m + m / SEQ) * D;
                sv[r] = ((const GAS float*)SSX)[(size_t)m * 16 + (lane & 15)];
#pragma unroll
                for (int j = 0; j < 2; ++j) rw[r][j] = *(const GAS u32x4*)(xr + 8 * lane + 512 * j); }
            f32x4 g0[2], g1[2];
#pragma unroll
            for (int j = 0; j < 2; ++j) { g0[j] = *(const GAS f32x4*)((const GAS float*)norm_final + 8 * lane + 512 * j); g1[j] = *(const GAS f32x4*)((const GAS float*)norm_final + 8 * lane + 512 * j + 4); }
#pragma unroll
            for (int r = 0; r < 4; ++r) { const int m = m0 + r; float s = sv[r];
                s += __shfl_xor(s, 1); s += __shfl_xor(s, 2); s += __shfl_xor(s, 4); s += __shfl_xor(s, 8);
                const float inv = 1.0f / sqrtf(s * (1.0f / D) + EPS);
                GAS float* orow = (GAS float*)out + (size_t)m * D;
#pragma unroll
                for (int j = 0; j < 2; ++j) { const u32x4 w = rw[r][j];
                    const f32x4 v0 = (f32x4){pg8::bf_lo(w.x), pg8::bf_hi(w.x), pg8::bf_lo(w.y), pg8::bf_hi(w.y)}, v1 = (f32x4){pg8::bf_lo(w.z), pg8::bf_hi(w.z), pg8::bf_lo(w.w), pg8::bf_hi(w.w)};
                    *(GAS f32x4*)(orow + 8 * lane + 512 * j) = v0 * inv * g0[j]; *(GAS f32x4*)(orow + 8 * lane + 512 * j + 4) = v1 * inv * g1[j]; } }
        }
    }
#undef IN
#undef SEAM
}

extern "C" void kernel_launch(void* const* d_in, const int* in_sizes, int n_in, void* d_out, int out_size, void* d_ws, size_t ws_size, hipStream_t stream) {
    static int grid = 0;
    if (grid == 0) {
        if (n_in != 14 || in_sizes[0] != SEQ * D || in_sizes[1] != 2 * SEQ * D || out_size != M * D || ws_size < WS_END) {
            fprintf(stderr, "kernel_launch: unexpected shapes (n_in %d, in0 %d, in1 %d, out %d, ws %zu; need ws >= %zu); nothing launched\n", n_in, n_in > 0 ? in_sizes[0] : -1, n_in > 1 ? in_sizes[1] : -1, out_size, ws_size, (size_t)WS_END);
            grid = -1; return; }
        int dev = 0, cus = 0;
        if (hipGetDevice(&dev) != hipSuccess || hipDeviceGetAttribute(&cus, hipDeviceAttributeMultiprocessorCount, dev) != hipSuccess) { fprintf(stderr, "kernel_launch: device query failed\n"); grid = -1; return; }
        if (hipFuncSetAttribute((const void*)fwd_kernel, hipFuncAttributeMaxDynamicSharedMemorySize, LDS_BYTES) != hipSuccess) { fprintf(stderr, "kernel_launch: hipFuncSetAttribute failed\n"); grid = -1; return; }
        int per_cu = 0;
        if (hipOccupancyMaxActiveBlocksPerMultiprocessor(&per_cu, (const void*)fwd_kernel, NWAVES * 64, LDS_BYTES) != hipSuccess || per_cu < 1)
            fprintf(stderr, "kernel_launch: note: occupancy query reports %d workgroups per CU\n", per_cu);
        (void)hipGetLastError();
        grid = cus;
    }
    if (grid < 0) return;
    if (hipMemsetAsync((char*)d_ws + WS_CTL, 0, CTL_ZERO_BYTES, stream) != hipSuccess) { fprintf(stderr, "kernel_launch: memset failed\n"); return; }
    Args a{};
    for (int i = 0; i < 14; ++i) a.in[i] = (const float*)d_in[i];
    a.out = (float*)d_out; a.ws = (unsigned char*)d_ws;
    if (MK_N_LAUNCHES == 1) {
        a.ph_lo = 0; a.ph_hi = N_PHASES; a.li = 0;
        hipLaunchKernelGGL(fwd_kernel, dim3(grid), dim3(NWAVES * 64), LDS_BYTES, stream, a);
    } else {
        for (int p = 0; p < N_PHASES; ++p) { a.ph_lo = p; a.ph_hi = p + 1; a.li = p; hipLaunchKernelGGL(fwd_kernel, dim3(grid), dim3(NWAVES * 64), LDS_BYTES, stream, a); }
    }
    const hipError_t le = hipPeekAtLastError();
    if (le != hipSuccess) fprintf(stderr, "kernel_launch: launch failed: %s\n", hipGetErrorName(le));
}
```

```cpp
#include <hip/hip_runtime.h>
#include <cstdio>
#include <cstdint>

#ifndef MK_N_LAUNCHES
#define MK_N_LAUNCHES 1
#endif

#ifndef REP_MASK
#define REP_MASK 0
#endif
#define LAS __attribute__((address_space(3)))
#define GAS __attribute__((address_space(1)))
typedef unsigned short bf16_t;
typedef short bf16x8 __attribute__((ext_vector_type(8)));
typedef short s16x4 __attribute__((ext_vector_type(4)));
typedef float f32x2 __attribute__((ext_vector_type(2)));
typedef float f32x4 __attribute__((ext_vector_type(4)));
typedef float f32x16 __attribute__((ext_vector_type(16)));
typedef unsigned u32x2 __attribute__((ext_vector_type(2)));
typedef unsigned u32x4 __attribute__((ext_vector_type(4)));
typedef __bf16 bf16x2_t __attribute__((ext_vector_type(2)));

constexpr int SEQ = 16384, NSEQ = 3, M = NSEQ * SEQ;
constexpr int D = 1024, NIN = 2304, DFF = 2816, NUP = 2 * DFF, DEPTH = 2;
constexpr int COL_QA = 0, COL_KA = 512, COL_VA = 1024, COL_QB = 1536, COL_KB = 2048, COL_VB = 2176;
constexpr float EPS = 1e-6f;
constexpr float LOG2E = 1.4426950408889634f;
constexpr float C2 = 0.125f * LOG2E;
#ifndef UP_WGM
#define UP_WGM 8
#endif
constexpr int UPM = 252;
constexpr int MP = M + NSEQ - 1;
constexpr int UP_NM = (MP + UPM - 1) / UPM;

constexpr size_t MiB = 1u << 20;
constexpr size_t WS_CTL = 0, CTL_ZERO_BYTES = 128 * 1024;
constexpr size_t W_IN_B = (size_t)NIN * D * 2, W_OUT_B = (size_t)D * D * 2, W_UP_B = (size_t)NUP * D * 2, W_DN_B = (size_t)D * DFF * 2;
constexpr size_t WS_W = 1 * MiB, W_LAYER_B = W_IN_B + W_OUT_B + W_UP_B + W_DN_B;
constexpr size_t WS_XB = 48 * MiB + 4096;
constexpr size_t WS_SSX = 146 * MiB, WS_SSA = 149 * MiB;
constexpr size_t WS_PROJ = 152 * MiB;
constexpr size_t WS_ATT = 368 * MiB;
constexpr size_t WS_HID = 152 * MiB;
constexpr size_t WS_END = 464 * MiB;
static_assert(WS_W + DEPTH * W_LAYER_B <= 48 * MiB && WS_XB + (size_t)(MP + 300) * D * 2 <= WS_SSX && WS_SSX + (size_t)M * 64 <= WS_SSA && WS_SSA + (size_t)M * 64 <= WS_PROJ, "ws map");
static_assert(WS_PROJ + (size_t)M * NIN * 2 <= WS_ATT && WS_ATT + (size_t)M * D * 2 <= WS_END && WS_HID + (size_t)M * DFF * 2 <= WS_END, "ws map");
constexpr int CW_BAR = 1024;
constexpr int CW_CNT = 4608;
constexpr size_t WS_CONV = 47 * MiB + 800 * 1024;
constexpr size_t WS_XSLOT = 47 * MiB;
#ifndef FUSE_FINAL
#define FUSE_FINAL 1
#endif

constexpr int RING_BYTES = 131072;
constexpr int MISC_OFF = RING_BYTES;
constexpr int TAB_OFF = RING_BYTES + 1024;
constexpr int TAB_BYTES = 26 * 1024;
constexpr int LDS_BYTES = TAB_OFF + TAB_BYTES;
constexpr int NWAVES = 8;

__device__ __forceinline__ unsigned cvtpk(float lo, float hi) { f32x2 v = {lo, hi}; bf16x2_t b = __builtin_convertvector(v, bf16x2_t); return __builtin_bit_cast(unsigned, b); }
__device__ __forceinline__ float wave_sum(float v) {
#pragma unroll
    for (int o = 1; o < 64; o <<= 1) v += __shfl_xor(v, o);
    return v;
}
__device__ __forceinline__ float dpp_shr1(float x) { return __int_as_float(__builtin_amdgcn_update_dpp(0, __float_as_int(x), 0x111, 0xf, 0xf, true)); }
__device__ __forceinline__ float dpp_shl1(float x) { return __int_as_float(__builtin_amdgcn_update_dpp(0, __float_as_int(x), 0x101, 0xf, 0xf, true)); }
__device__ __forceinline__ float swap_max(float v) { auto rr = __builtin_amdgcn_permlane32_swap(__float_as_uint(v), __float_as_uint(v), false, false); return fmaxf(__uint_as_float(rr[0]), __uint_as_float(rr[1])); }
__device__ __forceinline__ float swap_sum(float v) { auto rr = __builtin_amdgcn_permlane32_swap(__float_as_uint(v), __float_as_uint(v), false, false); return __uint_as_float(rr[0]) + __uint_as_float(rr[1]); }
__device__ __forceinline__ float sum_x16_x32(float v) {
    auto a = __builtin_amdgcn_permlane16_swap(__float_as_uint(v), __float_as_uint(v), false, false); v = __uint_as_float(a[0]) + __uint_as_float(a[1]);
    auto b = __builtin_amdgcn_permlane32_swap(__float_as_uint(v), __float_as_uint(v), false, false); return __uint_as_float(b[0]) + __uint_as_float(b[1]); }
#define LDS_WAIT() asm volatile("s_waitcnt lgkmcnt(0)" ::: "memory")
__device__ __forceinline__ void glds16(const void* gsrc, unsigned lds_dst) { unsigned keep;
    asm volatile("s_mov_b32 %0, m0\n\ts_mov_b32 m0, %2\n\ts_nop 0\n\tglobal_load_lds_dwordx4 %1, off\n\ts_mov_b32 m0, %0" : "=&s"(keep) : "v"(gsrc), "s"(lds_dst) : "memory"); }
__device__ __forceinline__ void glds16s(unsigned voff, const void* sbase, unsigned lds_dst) { unsigned keep;
    asm volatile("s_mov_b32 %0, m0\n\ts_mov_b32 m0, %3\n\ts_nop 0\n\tglobal_load_lds_dwordx4 %1, %2\n\ts_mov_b32 m0, %0" : "=&s"(keep) : "v"(voff), "s"(sbase), "s"(lds_dst) : "memory"); }
__device__ __forceinline__ int lane_now() { int l; asm volatile("v_mbcnt_lo_u32_b32 %0, -1, 0\n\tv_mbcnt_hi_u32_b32 %0, -1, %0" : "=v"(l)); return l; }
__device__ __forceinline__ void glds16s2(unsigned voff0, unsigned voff1, const void* sbase, unsigned lds_dst) {
    asm volatile("s_mov_b32 m0, %3\n\ts_nop 0\n\tglobal_load_lds_dwordx4 %0, %2\n\ts_add_u32 m0, m0, 0x2000\n\ts_nop 0\n\tglobal_load_lds_dwordx4 %1, %2"
                 :: "v"(voff0), "v"(voff1), "s"(sbase), "s"(lds_dst) : "m0", "scc", "memory"); }
__device__ __forceinline__ void glds16kv(unsigned voffk, unsigned voffv, const void* sk, const void* sv, unsigned lds_dst) {
    asm volatile("s_mov_b32 m0, %4\n\ts_nop 0\n\tglobal_load_lds_dwordx4 %0, %2\n\ts_add_u32 m0, m0, 0x2000\n\ts_nop 0\n\tglobal_load_lds_dwordx4 %1, %3"
                 :: "v"(voffk), "v"(voffv), "s"(sk), "s"(sv), "s"(lds_dst) : "m0", "scc", "memory"); }
#define VM_WAIT() asm volatile("s_waitcnt vmcnt(0)" ::: "memory")

namespace pg8 {
constexpr int BM = 256, BK = 64, HALF = 128, HTB = HALF * BK * 2, NXCD = 8, WGM = 8;
__host__ __device__ __forceinline__ int lds_byte(int r, int c) { const int st = (r >> 4) * 2 + (c >> 5), rr = r & 15, cc = c & 31, ob = rr * 64 + cc * 2; return st * 1024 + (ob ^ (((ob >> 9) & 1) << 5)); }
__host__ __device__ __forceinline__ void stage_rc(int b, int& R, int& C) { const int st = b / 1024, sb = b % 1024, swz = sb ^ (((sb >> 9) & 1) << 5); R = (st >> 1) * 16 + swz / 64; C = (st & 1) * 32 + (swz % 64) / 2; }
__host__ __device__ __forceinline__ int perm32(int rho) { const int n = rho >> 4, i = rho & 15; return 8 * (i >> 2) + 4 * n + (i & 3); }

struct Unit { int pm, pn; };
struct Gemm { const char* A; const char* Bt; int K; long a_tstep, a_hstep, b_tstep, b_hstep; int amap; long a_pad; };

struct StaticOrder {
    int nM, nN, nwg, G, c, wgm, rev;
    __device__ void init(int nM_, int nN_, int G_, int c_, int wgm_ = WGM, int rev_ = 0) { nM = nM_; nN = nN_; nwg = nM * nN; G = G_; c = c_; wgm = wgm_; rev = rev_; }
    __device__ bool next(int i, Unit& u) const {
        const long L = (long)i * G + c; if (L >= nwg) return false;
        int wgid = (int)L; { const int q = nwg / NXCD, r = nwg % NXCD, xcd = wgid % NXCD, off = wgid / NXCD; wgid = (xcd < r ? xcd * (q + 1) : r * (q + 1) + (xcd - r) * q) + off; }
        const int nig = wgm * nN, gid = wgid / nig, fm = gid * wgm, gsz = (nM - fm) < wgm ? (nM - fm) : wgm;
        u.pm = fm + ((wgid % nig) % gsz); u.pn = (wgid % nig) / gsz; if (rev) u.pm = nM - 1 - u.pm; return true;
    }
};

struct NoPre { __device__ __forceinline__ void operator()() const {} };
template <class Epi, bool ALIGN_EPI, bool EARLY_DRAIN = true, class Pre = NoPre>
__device__ __forceinline__ void gemm_phase(LAS unsigned char* lds, const Gemm g, const StaticOrder& S, const Epi& E, int wv, const Pre& pre = Pre()) {
    int tid_ = wv * 64 + lane_now(); asm volatile("" : "+v"(tid_));
    const int tid = tid_, wid = __builtin_amdgcn_readfirstlane(tid >> 6), lane = tid & 63, wr = wid >> 2, wc = wid & 3, fr = lane & 15, fq = lane >> 4;
    const int K = g.K, nt = K / BK;
    unsigned voffA[2], voffB[2];
#pragma unroll
    for (int i = 0; i < 2; ++i) { int R, C; stage_rc(tid * 16 + i * 8192, R, C); const int Rb = (R & ~31) + perm32(R & 31);
        const int Ra = g.amap ? (126 * (R >> 6) + 8 * (R & 15) + ((R >> 4) & 3)) : R;
        voffA[i] = (unsigned)(Ra * K + C) * 2u; voffB[i] = (unsigned)(Rb * K + C) * 2u; }
    const size_t kstep = (size_t)(BK * 2);
    const size_t ahs = (size_t)g.a_hstep, bhs = (size_t)g.b_hstep;
    const unsigned ldsw = (unsigned)wid * 1024u; const unsigned ldsn = (unsigned)(uintptr_t)lds + ldsw;
    const int aoff = lds_byte(wr * 64 + fr, fq * 8), boff = lds_byte(wc * 32 + fr, fq * 8);
#define PG8_SA(b, h) (((b) * 2 + (h)) * HTB)
#define PG8_SB(b, h) ((4 + (b) * 2 + (h)) * HTB)
#define PG8_STAGE(bufoff, gbase, voff) glds16s2((voff)[0], (voff)[1], (const void*)(gbase), ldsn + (unsigned)(bufoff))
#define PG8_LDA(dst, b, h) do { _Pragma("unroll") for (int m = 0; m < 4; ++m) _Pragma("unroll") for (int k = 0; k < 2; ++k) dst[m][k] = *(const LAS bf16x8*)(lds + PG8_SA(b, h) + aoff + m * 2048 + k * 1024); } while (0)
#define PG8_LDB(dst, b, h) do { _Pragma("unroll") for (int n = 0; n < 2; ++n) _Pragma("unroll") for (int k = 0; k < 2; ++k) dst[n][k] = *(const LAS bf16x8*)(lds + PG8_SB(b, h) + boff + n * 2048 + k * 1024); } while (0)
#define PG8_MMA(ai, bj, At, Bt) do { __builtin_amdgcn_s_setprio(1); _Pragma("unroll") for (int m = 0; m < 4; ++m) _Pragma("unroll") for (int n = 0; n < 2; ++n) _Pragma("unroll") for (int k = 0; k < 2; ++k) \
        acc[ai][bj][m][n] = __builtin_amdgcn_mfma_f32_16x16x32_bf16(Bt[n][k], At[m][k], acc[ai][bj][m][n], 0, 0, 0); __builtin_amdgcn_s_setprio(0); } while (0)
#define PG8_WAIT_V(n) asm volatile("s_waitcnt vmcnt(" #n ")" ::: "memory")
#define PG8_WAIT_V8_UNLESS(f) asm volatile("s_cmp_lg_u32 %0, 0\n\ts_cbranch_scc1 .Lpg8w%=\n\ts_waitcnt vmcnt(8)\n.Lpg8w%=:" :: "s"(f) : "scc", "memory")
#define PG8_WAIT_L(n) asm volatile("s_waitcnt lgkmcnt(" #n ")" ::: "memory")
#define PG8_BAR __builtin_amdgcn_s_barrier()
#define PG8_SCHED __builtin_amdgcn_sched_barrier(0)
    Unit cur, nxt; int ui = 0; bool fresh = false;
    if (!S.next(0, cur)) return;
    f32x4 acc[2][2][4][2];
#pragma unroll
    for (int a = 0; a < 2; ++a)
#pragma unroll
        for (int b = 0; b < 2; ++b)
#pragma unroll
            for (int m = 0; m < 4; ++m)
#pragma unroll
                for (int n = 0; n < 2; ++n) acc[a][b][m][n] = (f32x4){0.f, 0.f, 0.f, 0.f};
    bf16x8 At[4][2], B0[2][2], B1[2][2];
    const char* cA = g.A + (size_t)cur.pm * g.a_tstep + (size_t)(cur.pm >> 6) * g.a_pad; const char* cB = g.Bt + (size_t)cur.pn * g.b_tstep;
    if constexpr (Epi::HOOK) E.unit_start(cur, ui, wid, lane);
    PG8_STAGE(PG8_SB(0, 0), cB, voffB); PG8_STAGE(PG8_SB(0, 1), cB + bhs, voffB); PG8_STAGE(PG8_SA(0, 0), cA, voffA); PG8_STAGE(PG8_SA(0, 1), cA + ahs, voffA);
    pre();
    if (wr == 1) PG8_BAR;
    PG8_WAIT_V(2); PG8_BAR;
    PG8_STAGE(PG8_SB(1, 0), cB + kstep, voffB); PG8_STAGE(PG8_SA(1, 0), cA + kstep, voffA); PG8_STAGE(PG8_SB(1, 1), cB + bhs + kstep, voffB);
    PG8_WAIT_V(6); PG8_BAR;
    for (;;) {
        const bool has_next = S.next(ui + 1, nxt);
        const char* nA = has_next ? g.A + (size_t)nxt.pm * g.a_tstep + (size_t)(nxt.pm >> 6) * g.a_pad : cA; const char* nB = has_next ? g.Bt + (size_t)nxt.pn * g.b_tstep : cB;
        int landed_flag = fresh ? 1 : 0;
        for (int th = 0; th < nt; th += (Epi::MIDK ? nt / 2 : nt)) {
        if constexpr (Epi::MIDK) { if (th) E.midk(acc, ui, wr, fr); }
        for (int t = th; t < th + (Epi::MIDK ? nt / 2 : nt); t += 2) {
            const bool last = (t == nt - 2);
            const char* a1 = cA + (size_t)(t + 1) * kstep;
            const char* a2 = last ? nA : cA + (size_t)(t + 2) * kstep; const char* b2 = last ? nB : cB + (size_t)(t + 2) * kstep;
            const char* a3 = a2 + kstep; const char* b3 = b2 + kstep;
            int lf_ = EARLY_DRAIN ? __builtin_amdgcn_readfirstlane(landed_flag) : landed_flag; if constexpr (EARLY_DRAIN) asm volatile("" : "+s"(lf_)); landed_flag = 0;
            PG8_LDB(B0, 0, 0); PG8_LDB(B1, 0, 1); PG8_SCHED; PG8_LDA(At, 0, 0); PG8_STAGE(PG8_SA(1, 1), a1 + ahs, voffA);
            if (!lf_) PG8_WAIT_V(8);
            PG8_WAIT_L(0); PG8_BAR; PG8_MMA(0, 0, At, B0); PG8_MMA(0, 1, At, B1); PG8_BAR; PG8_SCHED;
            PG8_LDA(At, 0, 1); PG8_STAGE(PG8_SB(0, 0), b2, voffB); PG8_STAGE(PG8_SB(0, 1), b2 + bhs, voffB); PG8_STAGE(PG8_SA(0, 0), a2, voffA);
            if (!lf_) PG8_WAIT_V(8);
            PG8_WAIT_L(0); PG8_BAR; PG8_MMA(1, 0, At, B0); PG8_MMA(1, 1, At, B1); PG8_BAR; PG8_SCHED;
            PG8_LDB(B0, 1, 0); PG8_LDB(B1, 1, 1); PG8_SCHED; PG8_LDA(At, 1, 0); PG8_STAGE(PG8_SA(0, 1), a2 + ahs, voffA);
            if (!lf_) PG8_WAIT_V(8);
            PG8_WAIT_L(0); PG8_BAR; PG8_MMA(0, 0, At, B0); PG8_MMA(0, 1, At, B1); PG8_BAR; PG8_SCHED;
            PG8_LDA(At, 1, 1); PG8_STAGE(PG8_SB(1, 0), b3, voffB); PG8_STAGE(PG8_SB(1, 1), b3 + bhs, voffB); PG8_STAGE(PG8_SA(1, 0), a3, voffA);
            PG8_WAIT_V(8); PG8_WAIT_L(0); PG8_BAR; PG8_MMA(1, 0, At, B0); PG8_MMA(1, 1, At, B1); PG8_BAR; PG8_SCHED;
        }
        }
        if constexpr (ALIGN_EPI) { if (wr == 0) PG8_BAR; }
        if constexpr (EARLY_DRAIN) {
            PG8_STAGE(PG8_SA(1, 1), nA + kstep + ahs, voffA); if constexpr (!Epi::OWN_DRAIN) PG8_WAIT_V(0);
        }
        { int et_ = lane_now(); asm volatile("" : "+v"(et_)); const int efr = et_ & 15, efq = et_ >> 4;
          E(acc, cur, ui, wr, wc, efr, efq); }
        if (!has_next) break;
#pragma unroll
        for (int a = 0; a < 2; ++a)
#pragma unroll
            for (int b = 0; b < 2; ++b)
#pragma unroll
                for (int m = 0; m < 4; ++m)
#pragma unroll
                    for (int n = 0; n < 2; ++n) acc[a][b][m][n] = (f32x4){0.f, 0.f, 0.f, 0.f};
        cur = nxt; cA = nA; cB = nB; ++ui; fresh = EARLY_DRAIN;
        if constexpr (Epi::HOOK) { int ht_ = lane_now(); asm volatile("" : "+v"(ht_)); E.unit_start(cur, ui, wid, ht_); }
        if constexpr (ALIGN_EPI) { if (wr == 1) PG8_BAR; }
    }
    PG8_WAIT_V(0);
    if constexpr (!ALIGN_EPI) { if (wr == 0) PG8_BAR; }
    PG8_BAR;
#undef PG8_SA
#undef PG8_SB
#undef PG8_STAGE
#undef PG8_LDA
#undef PG8_LDB
#undef PG8_MMA
#undef PG8_WAIT_V
#undef PG8_WAIT_V8_UNLESS
#undef PG8_WAIT_L
#undef PG8_BAR
#undef PG8_SCHED
}

struct EpiProj {
    static constexpr bool MIDK = false, HOOK = false, OWN_DRAIN = false;
    bf16_t* O; const LAS float* rs;
    __device__ __forceinline__ void operator()(const f32x4 (&acc)[2][2][4][2], const Unit& u, int ui, int wr, int wc, int fr, int fq) const {
        const float sct = (u.pn < 2 || u.pn == 6 || u.pn == 7) ? C2 : 1.0f;
        const LAS float* rsu = rs + ui * 256;
#pragma unroll
        for (int ai = 0; ai < 2; ++ai)
#pragma unroll
            for (int m = 0; m < 4; ++m) { const int row = ai * HALF + wr * 64 + m * 16 + fr; const float sc = rsu[row] * sct;
                bf16_t* rowp = O + (size_t)(u.pm * BM + row) * NIN + u.pn * BM + wc * 32 + 8 * fq;
#pragma unroll
                for (int bj = 0; bj < 2; ++bj) { const f32x4 v0 = acc[ai][bj][m][0] * sc, v1 = acc[ai][bj][m][1] * sc;
                    u32x4 w; w.x = cvtpk(v0[0], v0[1]); w.y = cvtpk(v0[2], v0[3]); w.z = cvtpk(v1[0], v1[1]); w.w = cvtpk(v1[2], v1[3]);
                    *(u32x4*)(rowp + bj * HALF) = w; } }
    }
};
__device__ __forceinline__ float bf_lo(unsigned w) { return __uint_as_float(w << 16); }
__device__ __forceinline__ float bf_hi(unsigned w) { return __uint_as_float(w & 0xffff0000u); }
template <bool GRP> struct EpiRes {
    static constexpr bool MIDK = GRP, HOOK = false, OWN_DRAIN = false;
    bf16_t* xb; float* ssx; const LAS f32x2* rs2;
    __device__ __forceinline__ void midk(f32x4 (&acc)[2][2][4][2], int ui, int wr, int fr) const {
        const LAS f32x2* rsu = rs2 + ui * 256;
#pragma unroll
        for (int ai = 0; ai < 2; ++ai)
#pragma unroll
            for (int m = 0; m < 4; ++m) { const float ra = rsu[ai * HALF + wr * 64 + m * 16 + fr].x;
#pragma unroll
                for (int bj = 0; bj < 2; ++bj)
#pragma unroll
                    for (int n = 0; n < 2; ++n) acc[ai][bj][m][n] *= ra; }
    }
    __device__ __forceinline__ void operator()(const f32x4 (&acc)[2][2][4][2], const Unit& u, int ui, int wr, int wc, int fr, int fq) const {
        const int row0 = wr * 64 + fr, col0 = u.pn * BM + wc * 32 + 8 * fq;
        GAS bf16_t* xp0 = (GAS bf16_t*)xb + (size_t)(u.pm * BM + (u.pm >> 6) + row0) * D + col0;
        GAS float* sp = (GAS float*)ssx + (size_t)(u.pm * BM + row0) * 16 + u.pn * 4 + wc;
        const LAS f32x2* rsu = rs2 + ui * 256 + row0;
        u32x4 rw[2][4][2];
#pragma unroll
        for (int ai = 0; ai < 2; ++ai)
#pragma unroll
            for (int m = 0; m < 4; ++m)
#pragma unroll
                for (int bj = 0; bj < 2; ++bj) rw[ai][m][bj] = *(const GAS u32x4*)(xp0 + (size_t)(ai * HALF + m * 16) * D + bj * HALF);
        GAS bf16_t* xp = xp0;
#pragma unroll
        for (int ai = 0; ai < 2; ++ai)
#pragma unroll
            for (int m = 0; m < 4; ++m) {
                float sc = 1.0f; if constexpr (GRP) sc = rsu[ai * HALF + m * 16].y;
                float ss = 0.f;
#pragma unroll
                for (int bj = 0; bj < 2; ++bj) {
                    const u32x4 r = rw[ai][m][bj];
                    const f32x4 r0 = (f32x4){bf_lo(r.x), bf_hi(r.x), bf_lo(r.y), bf_hi(r.y)}, r1 = (f32x4){bf_lo(r.z), bf_hi(r.z), bf_lo(r.w), bf_hi(r.w)};
                    const f32x4 v0 = r0 + acc[ai][bj][m][0] * sc, v1 = r1 + acc[ai][bj][m][1] * sc;
                    u32x4 w; w.x = cvtpk(v0[0], v0[1]); w.y = cvtpk(v0[2], v0[3]); w.z = cvtpk(v1[0], v1[1]); w.w = cvtpk(v1[2], v1[3]);
                    *(GAS u32x4*)(xp + bj * HALF) = w;
                    ss += (v0[0] * v0[0] + v0[1] * v0[1]) + (v0[2] * v0[2] + v0[3] * v0[3]) + (v1[0] * v1[0] + v1[1] * v1[1]) + (v1[2] * v1[2] + v1[3] * v1[3]); }
                ss = sum_x16_x32(ss);
                if (fq == 0) *sp = ss;
                const int adv = (m == 3) ? (HALF - 48) : 16;
                xp += (size_t)adv * D; sp += adv * 16;
                asm volatile("" : "+v"(xp), "+v"(sp)); }
    }
};
struct EpiFin {
    static constexpr bool MIDK = false, HOOK = false, OWN_DRAIN = false;
    const bf16_t* xb; float* out; const float* gfin; float* xslot; unsigned* cnt; LAS unsigned char* scr;
    __device__ __forceinline__ void operator()(f32x4 (&acc)[2][2][4][2], const Unit& u, int ui, int wr, int wc, int fr, int fq) const {
        int tid_ = (wr * 4 + wc) * 64 + lane_now(); asm volatile("" : "+v"(tid_)); const int tid = tid_, lane = tid & 63;
        const int row0 = wr * 64 + fr, col0 = u.pn * BM + wc * 32 + 8 * fq;
        const GAS bf16_t* xp0 = (const GAS bf16_t*)xb + (size_t)(u.pm * BM + (u.pm >> 6) + row0) * D + col0;
        LAS float* P = (LAS float*)scr; LAS float* S = (LAS float*)(scr + 4096); volatile LAS unsigned* flag = (volatile LAS unsigned*)(scr + 5120);
        u32x4 rw[2][4][2];
#pragma unroll
        for (int ai = 0; ai < 2; ++ai)
#pragma unroll
            for (int m = 0; m < 4; ++m)
#pragma unroll
                for (int bj = 0; bj < 2; ++bj) rw[ai][m][bj] = *(const GAS u32x4*)(xp0 + (size_t)(ai * HALF + m * 16) * D + bj * HALF);
#pragma unroll
        for (int ai = 0; ai < 2; ++ai)
#pragma unroll
            for (int m = 0; m < 4; ++m) { float ss = 0.f;
#pragma unroll
                for (int bj = 0; bj < 2; ++bj) { const u32x4 r = rw[ai][m][bj];
                    acc[ai][bj][m][0] += (f32x4){bf_lo(r.x), bf_hi(r.x), bf_lo(r.y), bf_hi(r.y)}; acc[ai][bj][m][1] += (f32x4){bf_lo(r.z), bf_hi(r.z), bf_lo(r.w), bf_hi(r.w)};
                    const f32x4 v0 = acc[ai][bj][m][0], v1 = acc[ai][bj][m][1];
                    ss += (v0[0] * v0[0] + v0[1] * v0[1]) + (v0[2] * v0[2] + v0[3] * v0[3]) + (v1[0] * v1[0] + v1[1] * v1[1]) + (v1[2] * v1[2] + v1[3] * v1[3]); }
                ss = sum_x16_x32(ss);
                if (fq == 0) P[(ai * HALF + row0 + m * 16) * 4 + wc] = ss; }
        asm volatile("s_waitcnt lgkmcnt(0)" ::: "memory"); __builtin_amdgcn_s_barrier(); asm volatile("" ::: "memory");
        GAS float* slot = (GAS float*)xslot + ((size_t)u.pm * 256) * 4;
        if (tid < 256) { const f32x4 p = *(const LAS f32x4*)(P + tid * 4);
            __hip_atomic_store(slot + tid * 4 + u.pn, (p[0] + p[1]) + (p[2] + p[3]), __ATOMIC_RELAXED, __HIP_MEMORY_SCOPE_AGENT); }
        asm volatile("s_waitcnt vmcnt(0)" ::: "memory"); __builtin_amdgcn_s_barrier(); asm volatile("" ::: "memory");
        if (tid == 0) {
            __hip_atomic_fetch_add(cnt + 64 * u.pm, 1u, __ATOMIC_RELAXED, __HIP_MEMORY_SCOPE_AGENT);
            unsigned sp = 0, ok = 1;
            while (__hip_atomic_load(cnt + 64 * u.pm, __ATOMIC_RELAXED, __HIP_MEMORY_SCOPE_AGENT) < 4u) { __builtin_amdgcn_s_sleep(2); if (++sp > (1u << 22)) { ok = 0; break; } }
            __builtin_amdgcn_fence(__ATOMIC_ACQUIRE, "agent");
            flag[0] = ok;
        }
        asm volatile("s_waitcnt vmcnt(0) lgkmcnt(0)" ::: "memory"); __builtin_amdgcn_s_barrier(); asm volatile("" ::: "memory");
        if (tid < 256) { float t = 0.f;
#pragma unroll
            for (int k = 0; k < 4; ++k) t += __hip_atomic_load(slot + tid * 4 + k, __ATOMIC_RELAXED, __HIP_MEMORY_SCOPE_AGENT);
            S[tid] = (flag[0] != 0u) ? 1.0f / sqrtf(t * (1.0f / D) + EPS) : __builtin_nanf(""); }
        asm volatile("s_waitcnt vmcnt(0) lgkmcnt(0)" ::: "memory"); __builtin_amdgcn_s_barrier(); asm volatile("" ::: "memory");
        f32x4 g0[2], g1[2];
#pragma unroll
        for (int bj = 0; bj < 2; ++bj) { g0[bj] = *(const GAS f32x4*)((const GAS float*)gfin + col0 + bj * HALF); g1[bj] = *(const GAS f32x4*)((const GAS float*)gfin + col0 + bj * HALF + 4); }
        GAS float* op = (GAS float*)out + (size_t)(u.pm * BM + row0) * D + col0;
#pragma unroll
        for (int ai = 0; ai < 2; ++ai)
#pragma unroll
            for (int m = 0; m < 4; ++m) { const float iv = S[ai * HALF + row0 + m * 16];
#pragma unroll
                for (int bj = 0; bj < 2; ++bj) { *(GAS f32x4*)(op + bj * HALF) = acc[ai][bj][m][0] * iv * g0[bj]; *(GAS f32x4*)(op + bj * HALF + 4) = acc[ai][bj][m][1] * iv * g1[bj]; }
                const int adv = (m == 3) ? (HALF - 48) : 16; op += (size_t)adv * D; asm volatile("" : "+v"(op)); }
        asm volatile("s_waitcnt lgkmcnt(0)" ::: "memory"); __builtin_amdgcn_s_barrier(); asm volatile("" ::: "memory");
        (void)lane;
    }
};
struct EpiUp {
    static constexpr bool MIDK = false, HOOK = true, OWN_DRAIN = true;
    bf16_t* hid; const float* cws; const LAS float* rs; LAS unsigned char* cbuf;
    __device__ __forceinline__ void unit_start(const Unit& u, int ui, int wid, int lane) const {
        if (wid < 4) { const int a = 2 * wid + (lane >> 5);
            const float* src = cws + (size_t)(a & 3) * NUP + (a >= 4 ? DFF : 0) + u.pn * HALF + (lane & 31) * 4;
            glds16(src, (unsigned)__builtin_amdgcn_readfirstlane((unsigned)(uintptr_t)cbuf + (unsigned)((ui & 1) * 4096 + wid * 1024))); }
    }
    __device__ __forceinline__ void operator()(const f32x4 (&acc)[2][2][4][2], const Unit& u, int ui, int wr, int wc, int fr, int fq) const {
        const LAS float* rsu = rs + ui * 256 + wr * 64 + fr;
        float inv[8];
#pragma unroll
        for (int q = 0; q < 8; ++q) inv[q] = rsu[(q >> 2) * HALF + (q & 3) * 16];
        const int p0 = UPM * u.pm - 1 + 126 * wr + 8 * fr;
        const int cg = u.pn * HALF + wc * 32 + 8 * fq;
#pragma unroll
        for (int h = 0; h < 2; ++h) {
            unsigned pk[2][4][2];
#pragma unroll
            for (int n = 0; n < 2; ++n) {
                const LAS float* wl = (const LAS float*)(cbuf + (ui & 1) * 4096) + wc * 32 + 8 * fq + 4 * n;
#pragma unroll
                for (int ep = 0; ep < 2; ++ep) {
                    const LAS float* wp = wl + 2 * ep;
                    const f32x2 w0g = *(const LAS f32x2*)(wp), w1g = *(const LAS f32x2*)(wp + 128), w2g = *(const LAS f32x2*)(wp + 256), bg = *(const LAS f32x2*)(wp + 384);
                    const f32x2 w0v = *(const LAS f32x2*)(wp + 512), w1v = *(const LAS f32x2*)(wp + 640), w2v = *(const LAS f32x2*)(wp + 768), bv = *(const LAS f32x2*)(wp + 896);
                    float rr[2][4];
#pragma unroll
                    for (int e2 = 0; e2 < 2; ++e2) { const int e = 2 * ep + e2;
                        float xg[6], xv[6];
#pragma unroll
                        for (int i = 1; i < 5; ++i) { xg[i] = acc[h][0][i - 1][n][e] * inv[4 * h + i - 1]; xv[i] = acc[h][1][i - 1][n][e] * inv[4 * h + i - 1]; }
                        if (h == 0) { xg[0] = dpp_shr1(acc[1][0][3][n][e] * inv[7]); xv[0] = dpp_shr1(acc[1][1][3][n][e] * inv[7]); xg[5] = acc[1][0][0][n][e] * inv[4]; xv[5] = acc[1][1][0][n][e] * inv[4]; }
                        else        { xg[0] = acc[0][0][3][n][e] * inv[3]; xv[0] = acc[0][1][3][n][e] * inv[3]; xg[5] = dpp_shl1(acc[0][0][0][n][e] * inv[0]); xv[5] = dpp_shl1(acc[0][1][0][n][e] * inv[0]); }
#pragma unroll
                        for (int i = 1; i < 5; ++i) {
                            const float gc = __builtin_fmaf(w0g[e2], xg[i - 1], __builtin_fmaf(w1g[e2], xg[i], __builtin_fmaf(w2g[e2], xg[i + 1], bg[e2])));
                            const float vc = __builtin_fmaf(w0v[e2], xv[i - 1], __builtin_fmaf(w1v[e2], xv[i], __builtin_fmaf(w2v[e2], xv[i + 1], bv[e2])));
                            const float sg = gc * __builtin_amdgcn_rcpf(1.0f + __builtin_amdgcn_exp2f(gc));
                            rr[e2][i - 1] = sg * vc; }
                    }
#pragma unroll
                    for (int i = 0; i < 4; ++i) pk[n][i][ep] = cvtpk(rr[0][i], rr[1][i]);
                    __builtin_amdgcn_sched_barrier(0);
                }
            }
            if (h == 0) asm volatile("s_waitcnt vmcnt(0)" ::: "memory");
#pragma unroll
            for (int i = 0; i < 4; ++i) { const int q = 4 * h + i; const int j = 8 * fr + q; int p = p0 + q; asm volatile("" : "+v"(p));
                const int tok = p - (p > SEQ ? 1 : 0) - (p > 2 * SEQ + 1 ? 1 : 0);
                if (j >= 1 && j <= 126 && p < MP && p != SEQ && p != 2 * SEQ + 1) { u32x4 w; w.x = pk[0][i][0]; w.y = pk[0][i][1]; w.z = pk[1][i][0]; w.w = pk[1][i][1]; *(GAS u32x4*)((GAS bf16_t*)hid + (size_t)tok * DFF + cg) = w; } }
            __builtin_amdgcn_sched_barrier(0);
        }
    }
};
}

namespace att {
constexpr int PITCH = NIN * 2;
constexpr int SLOT = 16384;
__device__ __forceinline__ float vmax2(float a, float b) { return __builtin_elementwise_maximum(a, b); }
__device__ __forceinline__ float vmax3(float a, float b, float c) { return __builtin_elementwise_maximum(__builtin_elementwise_maximum(a, b), c); }
__device__ __forceinline__ float quad_max3(float m, float v) {
    auto a = __builtin_amdgcn_permlane16_swap(__float_as_uint(v), __float_as_uint(v), false, false); v = vmax2(__uint_as_float(a[0]), __uint_as_float(a[1]));
    auto b = __builtin_amdgcn_permlane32_swap(__float_as_uint(v), __float_as_uint(v), false, false); return vmax3(m, __uint_as_float(b[0]), __uint_as_float(b[1])); }
__device__ __forceinline__ float quad_sum(float v) {
    auto a = __builtin_amdgcn_permlane16_swap(__float_as_uint(v), __float_as_uint(v), false, false); v = __uint_as_float(a[0]) + __uint_as_float(a[1]);
    auto b = __builtin_amdgcn_permlane32_swap(__float_as_uint(v), __float_as_uint(v), false, false); return __uint_as_float(b[0]) + __uint_as_float(b[1]); }
#define WJ(j) ((j) == 0 ? 0 : (j) == 1 ? 8 : (j) == 2 ? 24 : 32)
template <int MODE>
__device__ __forceinline__ void block_unit(LAS unsigned char* ring, const bf16_t* proj, bf16_t* attn, float* ssa, int lane_, int wave,
                                           int ktok0, int nT, int kcol, int vcol, int act0, int actn,
                                           int qtok0, int half, int qcol, const LAS f32x4* bcp, int dr0, float slope2, float sink2, int outcol, int sscol,
                                           int& rbase, const bool pre, const char* nK, const char* nV, const bf16_t* nQ, bf16x8 (&qf)[2][2]) {
    int lane = lane_; asm volatile("" : "+v"(lane));
    const int qi = lane & 15, g = lane >> 4;
    const int rl = lane >> 3, cl = lane & 7;
    const unsigned loffk = (unsigned)((8 * wave + rl) * PITCH + ((cl ^ ((4 * (wave & 1) + (lane >> 4)) & 7)) << 4)), loffv = (unsigned)((8 * wave + rl) * PITCH + ((cl ^ (2 * (lane >> 4))) << 4));
    const char* kg = (const char*)(proj + (size_t)ktok0 * NIN + kcol);
    const char* vg = (const char*)(proj + (size_t)ktok0 * NIN + vcol);
    const unsigned ring0 = (unsigned)(uintptr_t)ring + (unsigned)wave * 1024u;
    const int base = rbase;
#define DMA_TILE(t) do { const unsigned sl_ = (unsigned)__builtin_amdgcn_readfirstlane(ring0 + (unsigned)(((t) + base) % 3) * SLOT); \
        glds16kv(loffk, loffv, kg + (size_t)(t) * 64 * PITCH, vg + (size_t)(t) * 64 * PITCH, sl_); } while (0)
#define DMA_NEXT(i) do { const unsigned sl_ = (unsigned)__builtin_amdgcn_readfirstlane(ring0 + (unsigned)((nT + (i) + base) % 3) * SLOT); \
        glds16kv(loffk, loffv, nK + (size_t)(i) * 64 * PITCH, nV + (size_t)(i) * 64 * PITCH, sl_); } while (0)
    const size_t qoff = (size_t)qi * NIN + 8 * g;
    if (!pre) { DMA_TILE(0); DMA_TILE(1);
#pragma unroll
        for (int jj = 0; jj < 2; ++jj)
#pragma unroll
            for (int ks = 0; ks < 2; ++ks) qf[jj][ks] = *(const GAS bf16x8*)((const GAS bf16_t*)proj + (size_t)(qtok0 + 16 * jj) * NIN + qcol + 32 * ks + qoff);
        __builtin_amdgcn_s_waitcnt(0x0F70);
    } else {
        __builtin_amdgcn_s_waitcnt(0x0F78);
    }
    f32x4 o[2][4];
    float mrun[2], lrun[2];
#pragma unroll
    for (int jj = 0; jj < 2; ++jj) {
#pragma unroll
        for (int dt = 0; dt < 4; ++dt) o[jj][dt] = (f32x4){0.f, 0.f, 0.f, 0.f};
        mrun[jj] = (MODE == 1) ? sink2 : -1e30f; lrun[jj] = (MODE == 1 && g == 0) ? 1.0f : 0.0f; }
    const int va = (lane & 15) >> 2, vb = lane & 3, sv = (2 * (g & 1) + (va >> 1)) & 3;
    int kofs[2], kad[2][2], vad[2], relm[2], bofs[2];
#pragma unroll
    for (int jj = 0; jj < 2; ++jj) {
        const int j = 2 * half + jj; const int koff = (MODE == 1) ? 0 : ((j == 0) ? 0 : (j == 1) ? 8 : (j == 2) ? 24 : 32);
        const int par = (koff >> 3) & 1, s0 = g ^ (qi >> 1);
        kofs[jj] = koff;
        kad[jj][0] = (koff + qi) * 128 + ((s0 ^ (4 * par)) << 4); kad[jj][1] = (koff + qi) * 128 + ((s0 ^ (4 * par) ^ 4) << 4);
        vad[jj] = 8192 + (koff + 4 * g + va) * 128 + vb * 8;
        const int c = 16 * j + qi, cs = min(max(c - 8, 0), 48);
        relm[jj] = koff + 4 * g - cs;
        const int raw = (MODE == 1) ? (ktok0 - (qtok0 + 16 * jj + qi) + 4 * g + 191) : (koff + 4 * g - c + 15 + 16); const int s4 = (3 - qi) & 3;
        bofs[jj] = s4 * ((MODE == 0) ? 968 : 768) + ((raw - s4) >> 2); }
    const float NEG = -INFINITY;
    f32x4 mneg[2][2];
#pragma unroll
    for (int jj = 0; jj < 2; ++jj)
#pragma unroll
        for (int kt = 0; kt < 2; ++kt)
#pragma unroll
            for (int e = 0; e < 4; ++e) mneg[jj][kt][e] = (MODE == 0 && !((unsigned)(relm[jj] + 16 * kt + e) < 16u)) ? NEG : 0.f;
    constexpr int NH = (MODE == 1) ? 2 : 1;
    auto head = [&](const int t) __attribute__((always_inline)) {
        if (t >= 2) { if (t + 1 < nT || nK) asm volatile("s_waitcnt vmcnt(2)" ::: "memory"); else asm volatile("s_waitcnt vmcnt(0)" ::: "memory"); }
        __builtin_amdgcn_s_barrier();
        if (t + 2 < nT) DMA_TILE(t + 2); else if (nK) DMA_NEXT(t + 2 - nT);
    };
    auto body = [&](const int t) __attribute__((always_inline)) {
        if (t >= act0 && t < act0 + actn) {
        const LAS unsigned char* Sl = ring + ((t + base) % 3) * SLOT;
#pragma unroll
        for (int hf = 0; hf < NH; ++hf) {
            if (MODE == 1) { const int ks = ktok0 + 64 * t + 32 * hf;
                if (ks + 31 < qtok0 - 128 || ks > qtok0 + 31 + 128) continue; }
            bf16x8 kf[2][2][2];
#pragma unroll
            for (int jj = 0; jj < 2; ++jj)
#pragma unroll
                for (int kt = 0; kt < 2; ++kt)
#pragma unroll
                    for (int ks = 0; ks < 2; ++ks) kf[jj][kt][ks] = *(const LAS bf16x8*)(Sl + kad[jj][ks] + (32 * hf + 16 * kt) * 128);
            f32x4 bb[2][2];
#pragma unroll
            for (int jj = 0; jj < 2; ++jj) { const LAS f32x4* bl = bcp + ((MODE == 0) ? (dr0 + t - act0) * 8 : 16 * t + 8 * hf) + bofs[jj];
#pragma unroll
                for (int kt = 0; kt < 2; ++kt) bb[jj][kt] = bl[4 * kt]; }
            s16x4 vlo[2][4], vhi[2][4];
#pragma unroll
            for (int jj = 0; jj < 2; ++jj)
#pragma unroll
                for (int dt = 0; dt < 4; ++dt) { const LAS unsigned char* vp = Sl + vad[jj] + (32 * hf) * 128 + ((dt ^ sv) << 5);
                    vlo[jj][dt] = __builtin_bit_cast(s16x4, __builtin_amdgcn_ds_read_tr16_b64_v4i16((LAS s16x4*)(vp)));
                    vhi[jj][dt] = __builtin_bit_cast(s16x4, __builtin_amdgcn_ds_read_tr16_b64_v4i16((LAS s16x4*)(vp + 2048))); }
            __builtin_amdgcn_sched_barrier(0);
            f32x4 s[2][2];
#pragma unroll
            for (int jj = 0; jj < 2; ++jj)
#pragma unroll
                for (int kt = 0; kt < 2; ++kt) { f32x4 a = (MODE == 0) ? bb[jj][kt] + mneg[jj][kt] : bb[jj][kt];
                    a = __builtin_amdgcn_mfma_f32_16x16x32_bf16(kf[jj][kt][0], qf[jj][0], a, 0, 0, 0);
                    s[jj][kt] = __builtin_amdgcn_mfma_f32_16x16x32_bf16(kf[jj][kt][1], qf[jj][1], a, 0, 0, 0); }
            u32x4 pw[2];
#pragma unroll
            for (int jj = 0; jj < 2; ++jj) {
                const float tm = vmax3(vmax3(s[jj][0][0], s[jj][0][1], s[jj][0][2]), vmax3(s[jj][0][3], s[jj][1][0], s[jj][1][1]), vmax3(s[jj][1][2], s[jj][1][3], s[jj][1][3]));
                const float mn = quad_max3(mrun[jj], tm);
                const float alpha = __builtin_amdgcn_exp2f(mrun[jj] - mn);
                mrun[jj] = mn;
                float rsum = 0.f;
#pragma unroll
                for (int kt = 0; kt < 2; ++kt)
#pragma unroll
                    for (int e = 0; e < 4; ++e) { s[jj][kt][e] = __builtin_amdgcn_exp2f(s[jj][kt][e] - mn); rsum += s[jj][kt][e]; }
                lrun[jj] = lrun[jj] * alpha + rsum;
#pragma unroll
                for (int dt = 0; dt < 4; ++dt) o[jj][dt] *= alpha;
                pw[jj].x = cvtpk(s[jj][0][0], s[jj][0][1]); pw[jj].y = cvtpk(s[jj][0][2], s[jj][0][3]); pw[jj].z = cvtpk(s[jj][1][0], s[jj][1][1]); pw[jj].w = cvtpk(s[jj][1][2], s[jj][1][3]);
            }
#pragma unroll
            for (int jj = 0; jj < 2; ++jj)
#pragma unroll
                for (int dt = 0; dt < 4; ++dt) {
                    const bf16x8 vf = (bf16x8){vlo[jj][dt][0], vlo[jj][dt][1], vlo[jj][dt][2], vlo[jj][dt][3], vhi[jj][dt][0], vhi[jj][dt][1], vhi[jj][dt][2], vhi[jj][dt][3]};
                    o[jj][dt] = __builtin_amdgcn_mfma_f32_16x16x32_bf16(vf, __builtin_bit_cast(bf16x8, pw[jj]), o[jj][dt], 0, 0, 0); }
            __builtin_amdgcn_sched_barrier(0);
        }
        }
    };
    for (int t = 0; t < nT - 1; ++t) { head(t); body(t); }
    head(nT - 1);
    bf16x8 qn[2][2];
    { const GAS bf16_t* qs = nQ ? (const GAS bf16_t*)nQ : (const GAS bf16_t*)proj + (size_t)qtok0 * NIN + qcol;
#pragma unroll
      for (int jj = 0; jj < 2; ++jj)
#pragma unroll
          for (int ks = 0; ks < 2; ++ks) qn[jj][ks] = *(const GAS bf16x8*)(qs + (size_t)(16 * jj) * NIN + 32 * ks + qoff); }
    body(nT - 1);
#undef DMA_TILE
#undef DMA_NEXT
    rbase = (base + nT) % 3;
    {
#pragma unroll
    for (int jj = 0; jj < 2; ++jj) {
        const float lt = quad_sum(lrun[jj]); const float il = 1.0f / lt;
        const int tok = qtok0 + 16 * jj + qi;
        float ss = 0.f;
#pragma unroll
        for (int dt = 0; dt < 4; ++dt) { const f32x4 v = o[jj][dt] * il;
            ss += (v[0] * v[0] + v[1] * v[1]) + (v[2] * v[2] + v[3] * v[3]);
            u32x2 w; w.x = cvtpk(v[0], v[1]); w.y = cvtpk(v[2], v[3]);
            *(GAS u32x2*)((GAS bf16_t*)attn + (size_t)tok * D + outcol + 16 * dt + 4 * g) = w; }
        ss = quad_sum(ss);
        if (g == 0) ((GAS float*)ssa)[(size_t)tok * 16 + sscol] = ss;
    }
    }
#pragma unroll
    for (int jj = 0; jj < 2; ++jj)
#pragma unroll
        for (int ks = 0; ks < 2; ++ks) { qf[jj][ks] = qn[jj][ks]; asm volatile("" : "+v"(qf[jj][ks])); }
    __builtin_amdgcn_s_barrier();
}
#undef WJ
}

#define XB_TMO      128
#define XB_XCNT(j)  (256  + 64 * (j))
#define XB_XSUB(j)  (1280 + 64 * (j))
#define XB_XGEN(j)  (2304 + 64 * (j))
#define XB_TOP      3328
#define XB_TOPGEN   3392
#define XCD_BAR_WORDS 3456
#define XB_SPIN_CAP (1u << 20)
__device__ __forceinline__ unsigned xb_ld(unsigned* p)              { return __hip_atomic_load(p, __ATOMIC_RELAXED, __HIP_MEMORY_SCOPE_AGENT); }
__device__ __forceinline__ unsigned xb_add(unsigned* p, unsigned v) { return __hip_atomic_fetch_add(p, v, __ATOMIC_RELAXED, __HIP_MEMORY_SCOPE_AGENT); }
__device__ __forceinline__ unsigned xb_xcc_id() { return (unsigned)__builtin_amdgcn_s_getreg((3 << 11) | 20) & 0xFu; }
#define XB_SPIN(cond, bar) do { unsigned _sp = 0; while (cond) { __builtin_amdgcn_s_sleep(1); \
    if ((++_sp & 255u) == 0u) { if (xb_ld(&(bar)[XB_TMO])) break; if (_sp > XB_SPIN_CAP) { atomicAdd(&(bar)[XB_TMO], 1u); break; } } } } while (0)
struct XcdBarrier { unsigned* bar; unsigned x; volatile LAS unsigned* st; };
__device__ __forceinline__ XcdBarrier xcd_barrier_post(unsigned* bar, volatile LAS unsigned* st) {
    XcdBarrier b; b.bar = bar; b.x = xb_xcc_id(); b.st = st;
    if (threadIdx.x == 0) (void)xb_add(&bar[XB_XCNT(b.x)], 1u);
    return b;
}
__device__ __forceinline__ void xcd_barrier_complete(unsigned* bar, unsigned x, unsigned& nloc, unsigned& nx) {
    const unsigned G = gridDim.x * gridDim.y * gridDim.z;
    unsigned sum, cnt, mine, sp = 0u;
    for (;;) {
        sum = 0u; cnt = 0u; mine = 0u;
#pragma unroll
        for (unsigned j = 0; j < 16; ++j) { const unsigned c = xb_ld(&bar[XB_XCNT(j)]); sum += c; cnt += (c > 0u) ? 1u : 0u; mine = (j == x) ? c : mine; }
        if (sum == G) break;
        __builtin_amdgcn_s_sleep(1);
        if ((++sp & 255u) == 0u) { if (xb_ld(&bar[XB_TMO])) break; if (sp > XB_SPIN_CAP) { atomicAdd(&bar[XB_TMO], 1u); break; } }
    }
    nloc = mine > 0u ? mine : 1u; nx = cnt > 0u ? cnt : 1u;
}
__device__ __forceinline__ void xcd_barrier(const XcdBarrier& b, int wv) {
    asm volatile("s_waitcnt vmcnt(0)" ::: "memory");
    __syncthreads();
    if (wv == 0 && lane_now() == 0) {
        unsigned* bar = b.bar;
        __builtin_amdgcn_s_waitcnt(0);
        unsigned nloc = b.st[0], nx = b.st[1];
        if (nloc == 0u) { xcd_barrier_complete(bar, b.x, nloc, nx); b.st[0] = nloc; b.st[1] = nx; }
        const unsigned old = xb_add(&bar[XB_XSUB(b.x)], 1u);
        const unsigned gen = old / nloc;
        if (old + 1u == (gen + 1u) * nloc) {
            __builtin_amdgcn_fence(__ATOMIC_RELEASE, "agent");
            asm volatile("s_waitcnt vmcnt(0)" ::: "memory");
            const unsigned og = xb_add(&bar[XB_TOP], 1u);
            const unsigned tg = og / nx;
            if (og + 1u == (tg + 1u) * nx) xb_add(&bar[XB_TOPGEN], 1u);
            else XB_SPIN(xb_ld(&bar[XB_TOPGEN]) == tg, bar);
            xb_add(&bar[XB_XGEN(b.x)], 1u);
            __builtin_amdgcn_fence(__ATOMIC_ACQUIRE, "agent");
            asm volatile("s_waitcnt vmcnt(0)" ::: "memory");
        } else {
            XB_SPIN(xb_ld(&bar[XB_XGEN(b.x)]) == gen, bar);
            __builtin_amdgcn_fence(__ATOMIC_ACQUIRE, "agent");
            asm volatile("s_waitcnt vmcnt(0)" ::: "memory");
        }
    }
    __syncthreads();
}

struct Args { const float* in[14]; float* out; unsigned char* ws; int ph_lo, ph_hi, li, pad; };
constexpr int N_PHASES = 2 + 5 * DEPTH;

__device__ __forceinline__ void transpose_item(const float* W, const float* gain, int K, int N, bf16_t* WT, LAS float* scr, int item, int lane) {
    const int nblk = N / 32, kb = item / nblk, nb = item % nblk, k0 = 64 * kb, n0 = 32 * nb;
    f32x4 wv[8]; float gk[8];
#pragma unroll
    for (int i = 0; i < 8; ++i) { const int kk = (lane >> 3) + 8 * i; wv[i] = *(const GAS f32x4*)((const GAS float*)W + (size_t)(k0 + kk) * N + n0 + 4 * (lane & 7)); gk[i] = gain ? gain[k0 + kk] : 1.0f; }
#pragma unroll
    for (int i = 0; i < 8; ++i) { const int kk = (lane >> 3) + 8 * i; LAS float* d = scr + kk * 33 + 4 * (lane & 7);
        d[0] = wv[i][0] * gk[i]; d[1] = wv[i][1] * gk[i]; d[2] = wv[i][2] * gk[i]; d[3] = wv[i][3] * gk[i]; }
    LDS_WAIT(); asm volatile("" ::: "memory");
    const int c = lane & 7;
#pragma unroll
    for (int j = 0; j < 4; ++j) { const int n = (lane >> 3) + 8 * j; const LAS float* s = scr + (8 * c) * 33 + n;
        u32x4 o; o.x = cvtpk(s[0 * 33], s[1 * 33]); o.y = cvtpk(s[2 * 33], s[3 * 33]); o.z = cvtpk(s[4 * 33], s[5 * 33]); o.w = cvtpk(s[6 * 33], s[7 * 33]);
        *(u32x4*)(WT + (size_t)(n0 + n) * K + k0 + 8 * c) = o; }
    LDS_WAIT(); asm volatile("" ::: "memory");
}

__global__ void __launch_bounds__(NWAVES * 64, 2) fwd_kernel(Args args) {
    extern __shared__ __attribute__((aligned(16))) unsigned char lds_raw[];
    LAS unsigned char* lds = (LAS unsigned char*)lds_raw;
    volatile LAS unsigned* MISC = (volatile LAS unsigned*)(lds + MISC_OFF);
    const int G = gridDim.x; const int bx = blockIdx.x; const int vcu = (G % 8 == 0) ? (bx % 8) * (G / 8) + bx / 8 : bx;
    unsigned char* ws = args.ws;
    unsigned* ctl = (unsigned*)(ws + WS_CTL);
    const float* x_p = args.in[0]; const float* x_s = args.in[1];
    const float* norm_mix = args.in[2]; const float* w_in = args.in[3]; const float* rpb = args.in[4]; const float* sinks = args.in[5];
    const float* norm_grp = args.in[6]; const float* w_out = args.in[7]; const float* norm_ffn = args.in[8]; const float* w_up = args.in[9];
    const float* conv_w = args.in[10]; const float* conv_b = args.in[11]; const float* w_down = args.in[12]; const float* norm_final = args.in[13];
    float* out = args.out;
    bf16_t* XB = (bf16_t*)(ws + WS_XB); float* SSX = (float*)(ws + WS_SSX); float* SSA = (float*)(ws + WS_SSA);
    bf16_t* PROJ = (bf16_t*)(ws + WS_PROJ); bf16_t* ATT = (bf16_t*)(ws + WS_ATT); bf16_t* HID = (bf16_t*)(ws + WS_HID);

    const int wave_s = __builtin_amdgcn_readfirstlane((int)(threadIdx.x >> 6));
    for (int u = threadIdx.x; u < 256; u += NWAVES * 64) ((LAS unsigned*)(lds + MISC_OFF))[u] = 0u;
    __syncthreads();
    XcdBarrier bar; bar.bar = ctl + CW_BAR; bar.x = 0; bar.st = nullptr;
    if (MK_N_LAUNCHES == 1) bar = xcd_barrier_post(ctl + CW_BAR, MISC + 8);
    const int lo = args.ph_lo, hi_ph = args.ph_hi;
#define PHASE_IDS int tid_ = wave_s * 64 + lane_now(); asm volatile("" : "+v"(tid_) :: "memory"); const int tid = tid_, lane = tid & 63, wave = wave_s; const int gw = vcu * NWAVES + wave, NGW = G * NWAVES; (void)lane; (void)gw; (void)NGW
#ifndef PH_MASK
#define PH_MASK 0x7f
#endif
#define KIND(k) ((k) == 0 ? 0 : ((k) == N_PHASES - 1 ? 6 : 1 + ((k) - 1) % 5))
#define IN(k) (((PH_MASK >> KIND(k)) & 1) && lo <= (k) && (k) < hi_ph)
#define SEAM(k) do { if (IN(k) && IN((k) + 1)) xcd_barrier(bar, wave_s); } while (0)

    for (int rep = 0; rep <= ((REP_MASK >> 0) & 1); ++rep) if (IN(0)) {
        PHASE_IDS;
        LAS float* scr = (LAS float*)(lds + wave * 16384);
        constexpr int I_IN = (D / 64) * (NIN / 32), I_OUT = (D / 64) * (D / 32), I_UP = (D / 64) * (NUP / 32), I_DN = (DFF / 64) * (D / 32), I_L = I_IN + I_OUT + I_UP + I_DN;
        for (int it = gw; it < DEPTH * I_L; it += NGW) {
            const int l = it / I_L; int r = it % I_L;
            unsigned char* wl = ws + WS_W + (size_t)l * W_LAYER_B;
            if (r < I_IN) { transpose_item(w_in + (size_t)l * D * NIN, norm_mix + l * D, D, NIN, (bf16_t*)wl, scr, r, lane); continue; } r -= I_IN;
            if (r < I_OUT) { transpose_item(w_out + (size_t)l * D * D, norm_grp + l * D, D, D, (bf16_t*)(wl + W_IN_B), scr, r, lane); continue; } r -= I_OUT;
            if (r < I_UP) { transpose_item(w_up + (size_t)l * D * NUP, norm_ffn + l * D, D, NUP, (bf16_t*)(wl + W_IN_B + W_OUT_B), scr, r, lane); continue; } r -= I_UP;
            transpose_item(w_down + (size_t)l * DFF * D, nullptr, DFF, D, (bf16_t*)(wl + W_IN_B + W_OUT_B + W_UP_B), scr, r, lane);
        }
        for (int m0 = 4 * gw; m0 < M; m0 += 4 * NGW) {
            f32x4 v[4][4];
#pragma unroll
            for (int r = 0; r < 4; ++r) { const int m = m0 + r; const GAS float* xr = (m < SEQ) ? (const GAS float*)x_p + (size_t)m * D : (const GAS float*)x_s + (size_t)(m - SEQ) * D;
#pragma unroll
                for (int j = 0; j < 4; ++j) v[r][j] = *(const GAS f32x4*)(xr + 4 * lane + 256 * j); }
#pragma unroll
            for (int r = 0; r < 4; ++r) { const int m = m0 + r; float s = 0.f;
#pragma unroll
                for (int j = 0; j < 4; ++j) s += (v[r][j][0] * v[r][j][0] + v[r][j][1] * v[r][j][1]) + (v[r][j][2] * v[r][j][2] + v[r][j][3] * v[r][j][3]);
                s = wave_sum(s);
#pragma unroll
                for (int j = 0; j < 4; ++j) { u32x2 w; w.x = cvtpk(v[r][j][0], v[r][j][1]); w.y = cvtpk(v[r][j][2], v[r][j][3]); *(GAS u32x2*)((GAS bf16_t*)XB + (size_t)(m + m / SEQ) * D + 4 * lane + 256 * j) = w; }
                if (lane < 16) ((GAS float*)SSX)[(size_t)m * 16 + lane] = s * (1.0f / 16.0f); }
        }
        for (int i = gw * 64 + lane; i < DEPTH * 4 * NUP; i += NGW * 64) {
            const int c = i % NUP, a = (i / NUP) & 3, l2 = i / (4 * NUP);
            const float v = (a < 3) ? conv_w[((size_t)l2 * 3 + a) * NUP + c] : conv_b[(size_t)l2 * NUP + c];
            ((float*)(ws + WS_CONV))[i] = v * ((c < DFF) ? -LOG2E : -1.0f / LOG2E); }
        for (int z = gw; z < 3 + 300; z += NGW) {
            const long prow = (z == 0) ? -1 : (z == 1) ? SEQ : (z == 2) ? 2 * SEQ + 1 : (long)MP + (z - 3);
#pragma unroll
            for (int j = 0; j < 4; ++j) *(u32x2*)(XB + prow * D + 4 * lane + 256 * j) = (u32x2){0u, 0u};
        }
    }
    SEAM(0);

    for (int l = 0; l < DEPTH; ++l) {
        const int pb = 1 + 5 * l;
        const unsigned char* wl = ws + WS_W + (size_t)l * W_LAYER_B;
        const char* Win_t = (const char*)wl; const char* Wout_t = (const char*)(wl + W_IN_B); const char* Wup_t = (const char*)(wl + W_IN_B + W_OUT_B); const char* Wdn_t = (const char*)(wl + W_IN_B + W_OUT_B + W_UP_B);

        for (int rep = 0; rep <= ((REP_MASK >> 1) & 1); ++rep) if (IN(pb)) {
            PHASE_IDS;
            pg8::StaticOrder S; S.init(M / 256, NIN / 256, G, bx);
            LAS float* tab = (LAS float*)(lds + TAB_OFF);
            auto pre = [&]() __attribute__((always_inline))
            { pg8::Unit u; for (int i = wave >> 2; S.next(i, u); i += 2)       { const int row = tid & 255; const float* p = SSX + (size_t)(u.pm * 256 + row) * 16;
                const f32x4 a = *(const f32x4*)p, b = *(const f32x4*)(p + 4), c = *(const f32x4*)(p + 8), d = *(const f32x4*)(p + 12);
                const float s = ((a[0] + a[1]) + (a[2] + a[3])) + ((b[0] + b[1]) + (b[2] + b[3])) + ((c[0] + c[1]) + (c[2] + c[3])) + ((d[0] + d[1]) + (d[2] + d[3]));
                tab[i * 256 + row] = 1.0f / sqrtf(s * (1.0f / D) + EPS); } }
            ;
            pg8::Gemm g{(const char*)XB, Win_t, D, 256L * D * 2, 128L * D * 2, 256L * D * 2, 128L * D * 2, 0, (long)D * 2};
            pg8::EpiProj E{PROJ, tab};
            pg8::gemm_phase<pg8::EpiProj, true, true, decltype(pre)>(lds, g, S, E, wave, pre);
        }
        SEAM(pb);

        for (int rep = 0; rep <= ((REP_MASK >> 2) & 1); ++rep) if (IN(pb + 1)) {
            PHASE_IDS;
            LAS float* tab = (LAS float*)(lds + TAB_OFF);
            for (int i = tid; i < 8 * 15 * 32; i += NWAVES * 64) { const int h = i / 480, rem = i % 480, dr = rem >> 5, o = rem & 31;
                tab[i] = (o < 31) ? rpb[((size_t)(l * 8 + h) * 15 + dr) * 31 + o] * LOG2E : 0.f; }
            if (tid < 16) tab[8 * 15 * 32 + tid] = 0.f;
            __syncthreads();
            LAS f32x4* cpy = (LAS f32x4*)(lds + 65536);
            for (int i = tid; i < 4 * 968; i += NWAVES * 64) { const int sft = i / 968, k = i % 968; f32x4 v;
#pragma unroll
                for (int e = 0; e < 4; ++e) { const int x = 4 * k + sft + e - 16; v[e] = (x >= 0 && x < 8 * 15 * 32 + 16) ? tab[min(max(x, 0), 8 * 15 * 32 + 15)] : 0.f; }
                cpy[i] = v; }
            __syncthreads();
            int rbase = 0; bool pre = false; bf16x8 qf[2][2] = {};
            auto kbase_n = [&](int n, const char*& K0, const char*& V0) __attribute__((always_inline)) { const int r4 = n & 63, h = (n >> 6) & 7, sq = n >> 9; const int rs0 = min(max(4 * r4 - 4, 0), 248);
                const bf16_t* b = PROJ + (size_t)(sq * SEQ + rs0 * 64) * NIN; K0 = (const char*)(b + COL_KA + h * 64); V0 = (const char*)(b + COL_VA + h * 64); };
            auto kbase_s = [&](int n, const char*& K0, const char*& V0) __attribute__((always_inline)) { const int tt = n & 255, kvh = (n >> 8) & 1, sq = n >> 9; const int u_lo = max(64 * tt - 128, 0);
                const bf16_t* b = PROJ + (size_t)(sq * SEQ + u_lo) * NIN; K0 = (const char*)(b + COL_KB + kvh * 64); V0 = (const char*)(b + COL_VB + kvh * 64); };
            for (int rp = 0; rp <= ((REP_MASK >> 8) & 1); ++rp)
            for (int n = vcu; n < 1536; n += G) {
                const int r4 = n & 63, h = (n >> 6) & 7, sq = n >> 9; const int r0 = 4 * r4, r = r0 + (wave >> 1);
                const int rs0 = min(max(r0 - 4, 0), 248), rs3 = min(max(r0 - 1, 0), 248), rs = min(max(r - 4, 0), 248);
                const char* nK = nullptr; const char* nV = nullptr;
                const bf16_t* nQ = nullptr;
                if (n + G < 1536) { kbase_n(n + G, nK, nV); const int n2 = n + G; nQ = PROJ + (size_t)((n2 >> 9) * SEQ + (4 * (n2 & 63) + (wave >> 1)) * 64 + 32 * (wave & 1)) * NIN + COL_QA + ((n2 >> 6) & 7) * 64; }
                else if (REP_MASK == 0 && vcu < 1536) { kbase_s(vcu, nK, nV); const int n2 = vcu; nQ = PROJ + (size_t)((n2 >> 9) * SEQ + 64 * (n2 & 255) + 32 * (wave >> 2)) * NIN + COL_QB + (4 * ((n2 >> 8) & 1) + (wave & 3)) * 64; }
                att::block_unit<0>(lds, PROJ, ATT, SSA, lane, wave, sq * SEQ + rs0 * 64, rs3 + 8 - rs0, COL_KA + h * 64, COL_VA + h * 64, rs - rs0, 8,
                                   sq * SEQ + r * 64 + 32 * (wave & 1), wave & 1, COL_QA + h * 64, cpy + h * 120, rs - r + 7, 0.f, 0.f, h * 64, h, rbase, pre, nK, nV, nQ, qf);
                pre = (nK != nullptr);
            }
            __syncthreads();
            for (int i = tid; i < 8 * 384; i += NWAVES * 64) { const int h = i / 384, dd = abs(i % 384 - 191);
                tab[i] = (dd <= 128) ? -__builtin_amdgcn_exp2f(-(float)(h + 1)) * LOG2E * (float)dd : -INFINITY; }
            __syncthreads();
            for (int i = tid; i < 4 * 768; i += NWAVES * 64) { const int sft = i / 768, k = i % 768; f32x4 v;
#pragma unroll
                for (int e = 0; e < 4; ++e) { const int x = 4 * k + sft + e; v[e] = (x < 8 * 384) ? tab[min(x, 8 * 384 - 1)] : -INFINITY; }
                cpy[i] = v; }
            __syncthreads();
            float sinkA = sinks[l * 8 + (wave & 3)] * LOG2E, sinkB = sinks[l * 8 + 4 + (wave & 3)] * LOG2E;
            __builtin_amdgcn_s_waitcnt(0x0F70); asm volatile("" : "+v"(sinkA), "+v"(sinkB));
            for (int rp = 0; rp <= ((REP_MASK >> 9) & 1); ++rp)
            for (int n = vcu; n < 1536; n += G) {
                const int tt = n & 255, kvh = (n >> 8) & 1, sq = n >> 9; const int hb = 4 * kvh + (wave & 3), t0 = 64 * tt;
                const int u_lo = max(t0 - 128, 0), u_hi = min(t0 + 192, SEQ);
                const float slope2 = __builtin_amdgcn_exp2f(-(float)(hb + 1)) * LOG2E; const float sink2 = kvh ? sinkB : sinkA;
                const char* nK = nullptr; const char* nV = nullptr;
                const bf16_t* nQ = nullptr;
                if (n + G < 1536) { kbase_s(n + G, nK, nV); const int n2 = n + G; nQ = PROJ + (size_t)((n2 >> 9) * SEQ + 64 * (n2 & 255) + 32 * (wave >> 2)) * NIN + COL_QB + (4 * ((n2 >> 8) & 1) + (wave & 3)) * 64; }
                att::block_unit<1>(lds, PROJ, ATT, SSA, lane, wave, sq * SEQ + u_lo, (u_hi - u_lo) >> 6, COL_KB + kvh * 64, COL_VB + kvh * 64, 0, (u_hi - u_lo) >> 6,
                                   sq * SEQ + t0 + 32 * (wave >> 2), wave >> 2, COL_QB + hb * 64, cpy + hb * 96, 0, slope2, sink2, 512 + hb * 64, 8 + hb, rbase, pre, nK, nV, nQ, qf);
                pre = (nK != nullptr);
            }
            __syncthreads();
        }
        SEAM(pb + 1);

        if (IN(pb + 2)) {
            PHASE_IDS;
            pg8::StaticOrder S; S.init(M / 256, D / 256, G, bx);
            LAS f32x2* tab = (LAS f32x2*)(lds + TAB_OFF);
            auto pre = [&]() __attribute__((always_inline))
            { pg8::Unit u; for (int i = wave >> 2; S.next(i, u); i += 2)       { const int row = tid & 255; const float* p = SSA + (size_t)(u.pm * 256 + row) * 16;
                const f32x4 a = *(const f32x4*)p, b = *(const f32x4*)(p + 4), c = *(const f32x4*)(p + 8), d = *(const f32x4*)(p + 12);
                const float sa = ((a[0] + a[1]) + (a[2] + a[3])) + ((b[0] + b[1]) + (b[2] + b[3])), sb = ((c[0] + c[1]) + (c[2] + c[3])) + ((d[0] + d[1]) + (d[2] + d[3]));
                const float ia = 1.0f / sqrtf(sa * (1.0f / 512.f) + EPS), ib = 1.0f / sqrtf(sb * (1.0f / 512.f) + EPS);
                tab[i * 256 + row] = (f32x2){ia / ib, ib}; } }
            ;
            pg8::Gemm g{(const char*)ATT, Wout_t, D, 256L * D * 2, 128L * D * 2, 256L * D * 2, 128L * D * 2, 0, 0L};
            pg8::EpiRes<true> E{XB, SSX, tab};
            pg8::gemm_phase<pg8::EpiRes<true>, true, false, decltype(pre)>(lds, g, S, E, wave, pre);
        }
        SEAM(pb + 2);

        for (int rep = 0; rep <= ((REP_MASK >> 4) & 1); ++rep) if (IN(pb + 3)) {
            PHASE_IDS;
            pg8::StaticOrder S; S.init(UP_NM, DFF / 128, G, bx, UP_WGM);
            LAS float* tab = (LAS float*)(lds + TAB_OFF);
            { pg8::Unit u; for (int i = wave >> 2; S.next(i, u); i += 2)       { const int row = tid & 255; const int ai = row >> 7, wr = (row >> 6) & 1, m = (row >> 4) & 3, fr = row & 15;
                const int pp = UPM * u.pm - 1 + 126 * wr + 8 * fr + 4 * ai + m;
                const int tok = min(max(pp - (pp > SEQ ? 1 : 0) - (pp > 2 * SEQ + 1 ? 1 : 0), 0), M - 1);
                const float* p = SSX + (size_t)tok * 16;
                const f32x4 a = *(const f32x4*)p, b = *(const f32x4*)(p + 4), c = *(const f32x4*)(p + 8), d = *(const f32x4*)(p + 12);
                const float s = ((a[0] + a[1]) + (a[2] + a[3])) + ((b[0] + b[1]) + (b[2] + b[3])) + ((c[0] + c[1]) + (c[2] + c[3])) + ((d[0] + d[1]) + (d[2] + d[3]));
                tab[i * 256 + row] = (pp >= 0 && pp < MP && pp != SEQ && pp != 2 * SEQ + 1) ? 1.0f / sqrtf(s * (1.0f / D) + EPS) : 0.f; } }
            __syncthreads();
            pg8::Gemm g{(const char*)(XB - D), Wup_t, D, (long)UPM * D * 2, 4L * D * 2, 128L * D * 2, (long)DFF * D * 2, 1, 0L};
            pg8::EpiUp E{HID, (const float*)(ws + WS_CONV) + (size_t)l * 4 * NUP, tab, lds + TAB_OFF + 18 * 1024};
            pg8::gemm_phase<pg8::EpiUp, true, true>(lds, g, S, E, wave);
        }
        SEAM(pb + 3);

        if (IN(pb + 4)) {
            PHASE_IDS;
            pg8::StaticOrder S; S.init(M / 256, D / 256, G, bx, pg8::WGM, 1);
            pg8::Gemm g{(const char*)HID, Wdn_t, DFF, 256L * DFF * 2, 128L * DFF * 2, 256L * DFF * 2, 128L * DFF * 2, 0, 0L};
            if (l == DEPTH - 1 && FUSE_FINAL) {
                pg8::EpiFin E{XB, out, norm_final, (float*)(ws + WS_XSLOT), ctl + CW_CNT, lds + TAB_OFF};
                pg8::gemm_phase<pg8::EpiFin, true, false>(lds, g, S, E, wave);
            } else {
                pg8::EpiRes<false> E{XB, SSX, nullptr};
                pg8::gemm_phase<pg8::EpiRes<false>, true, false>(lds, g, S, E, wave);
            }
        }
        if (!(FUSE_FINAL && l == DEPTH - 1)) SEAM(pb + 4);
    }

    if (!FUSE_FINAL) for (int rep = 0; rep <= ((REP_MASK >> 6) & 1); ++rep) if (IN(N_PHASES - 1)) {
        PHASE_IDS;
        for (int m0 = 4 * gw; m0 < M; m0 += 4 * NGW) {
            u32x4 rw[4][2]; float sv[4];
#pragma unroll
            for (int r = 0; r < 4; ++r) { const int m = m0 + r; const GAS bf16_t* xr = (const GAS bf16_t*)XB + (size_t)(m + m / SEQ) * D;
                sv[r] = ((const GAS float*)SSX)[(size_t)m * 16 + (lane & 15)];
#pragma unroll
                for (int j = 0; j < 2; ++j) rw[r][j] = *(const GAS u32x4*)(xr + 8 * lane + 512 * j); }
            f32x4 g0[2], g1[2];
#pragma unroll
            for (int j = 0; j < 2; ++j) { g0[j] = *(const GAS f32x4*)((const GAS float*)norm_final + 8 * lane + 512 * j); g1[j] = *(const GAS f32x4*)((const GAS float*)norm_final + 8 * lane + 512 * j + 4); }
#pragma unroll
            for (int r = 0; r < 4; ++r) { const int m = m0 + r; float s = sv[r];
                s += __shfl_xor(s, 1); s += __shfl_xor(s, 2); s += __shfl_xor(s, 4); s += __shfl_xor(s, 8);
                const float inv = 1.0f / sqrtf(s * (1.0f / D) + EPS);
                GAS float* orow = (GAS float*)out + (size_t)m * D;
#pragma unroll
                for (int j = 0; j < 2; ++j) { const u32x4 w = rw[r][j];
                    const f32x4 v0 = (f32x4){pg8::bf_lo(w.x), pg8::bf_hi(w.x), pg8::bf_lo(w.y), pg8::bf_hi(w.y)}, v1 = (f32x4){pg8::bf_lo(w.z), pg8::bf_hi(w.z), pg8::bf_lo(w.w), pg8::bf_hi(w.w)};
                    *(GAS f32x4*)(orow + 8 * lane + 512 * j) = v0 * inv * g0[j]; *(GAS f32x4*)(orow + 8 * lane + 512 * j + 4) = v1 * inv * g1[j]; } }
        }
    }
#undef IN
#undef SEAM
}

extern "C" void kernel_launch(void* const* d_in, const int* in_sizes, int n_in, void* d_out, int out_size, void* d_ws, size_t ws_size, hipStream_t stream) {
    static int grid = 0;
    if (grid == 0) {
        if (n_in != 14 || in_sizes[0] != SEQ * D || in_sizes[1] != 2 * SEQ * D || out_size != M * D || ws_size < WS_END) {
            fprintf(stderr, "kernel_launch: unexpected shapes (n_in %d, in0 %d, in1 %d, out %d, ws %zu; need ws >= %zu); nothing launched\n", n_in, n_in > 0 ? in_sizes[0] : -1, n_in > 1 ? in_sizes[1] : -1, out_size, ws_size, (size_t)WS_END);
            grid = -1; return; }
        int dev = 0, cus = 0;
        if (hipGetDevice(&dev) != hipSuccess || hipDeviceGetAttribute(&cus, hipDeviceAttributeMultiprocessorCount, dev) != hipSuccess) { fprintf(stderr, "kernel_launch: device query failed\n"); grid = -1; return; }
        if (hipFuncSetAttribute((const void*)fwd_kernel, hipFuncAttributeMaxDynamicSharedMemorySize, LDS_BYTES) != hipSuccess) { fprintf(stderr, "kernel_launch: hipFuncSetAttribute failed\n"); grid = -1; return; }
        int per_cu = 0;
        if (hipOccupancyMaxActiveBlocksPerMultiprocessor(&per_cu, (const void*)fwd_kernel, NWAVES * 64, LDS_BYTES) != hipSuccess || per_cu < 1)
            fprintf(stderr, "kernel_launch: note: occupancy query reports %d workgroups per CU\n", per_cu);
        (void)hipGetLastError();
        grid = cus;
    }
    if (grid < 0) return;
    if (hipMemsetAsync((char*)d_ws + WS_CTL, 0, CTL_ZERO_BYTES, stream) != hipSuccess) { fprintf(stderr, "kernel_launch: memset failed\n"); return; }
    Args a{};
    for (int i = 0; i < 14; ++i) a.in[i] = (const float*)d_in[i];
    a.out = (float*)d_out; a.ws = (unsigned char*)d_ws;
    if (MK_N_LAUNCHES == 1) {
        a.ph_lo = 0; a.ph_hi = N_PHASES; a.li = 0;
        hipLaunchKernelGGL(fwd_kernel, dim3(grid), dim3(NWAVES * 64), LDS_BYTES, stream, a);
    } else {
        for (int p = 0; p < N_PHASES; ++p) { a.ph_lo = p; a.ph_hi = p + 1; a.li = p; hipLaunchKernelGGL(fwd_kernel, dim3(grid), dim3(NWAVES * 64), LDS_BYTES, stream, a); }
    }
    const hipError_t le = hipPeekAtLastError();
    if (le != hipSuccess) fprintf(stderr, "kernel_launch: launch failed: %s\n", hipGetErrorName(le));
}
```

```cpp
#include <hip/hip_runtime.h>
#include <cstdio>
#include <cstdint>

#ifndef MK_N_LAUNCHES
#define MK_N_LAUNCHES 1
#endif

#ifndef REP_MASK
#define REP_MASK 0
#endif
#define LAS __attribute__((address_space(3)))
#define GAS __attribute__((address_space(1)))
typedef unsigned short bf16_t;
typedef short bf16x8 __attribute__((ext_vector_type(8)));
typedef short s16x4 __attribute__((ext_vector_type(4)));
typedef float f32x2 __attribute__((ext_vector_type(2)));
typedef float f32x4 __attribute__((ext_vector_type(4)));
typedef float f32x16 __attribute__((ext_vector_type(16)));
typedef unsigned u32x2 __attribute__((ext_vector_type(2)));
typedef unsigned u32x4 __attribute__((ext_vector_type(4)));
typedef __bf16 bf16x2_t __attribute__((ext_vector_type(2)));

constexpr int SEQ = 16384, NSEQ = 3, M = NSEQ * SEQ;
constexpr int D = 1024, NIN = 2304, DFF = 2816, NUP = 2 * DFF, DEPTH = 2;
constexpr int COL_QA = 0, COL_KA = 512, COL_VA = 1024, COL_QB = 1536, COL_KB = 2048, COL_VB = 2176;
constexpr float EPS = 1e-6f;
constexpr float LOG2E = 1.4426950408889634f;
constexpr float C2 = 0.125f * LOG2E;
#ifndef UP_WGM
#define UP_WGM 8
#endif
constexpr int UPM = 252;
constexpr int MP = M + NSEQ - 1;
constexpr int UP_NM = (MP + UPM - 1) / UPM;

constexpr size_t MiB = 1u << 20;
constexpr size_t WS_CTL = 0, CTL_ZERO_BYTES = 128 * 1024;
constexpr size_t W_IN_B = (size_t)NIN * D * 2, W_OUT_B = (size_t)D * D * 2, W_UP_B = (size_t)NUP * D * 2, W_DN_B = (size_t)D * DFF * 2;
constexpr size_t WS_W = 1 * MiB, W_LAYER_B = W_IN_B + W_OUT_B + W_UP_B + W_DN_B;
constexpr size_t WS_XB = 48 * MiB + 4096;
constexpr size_t WS_SSX = 146 * MiB, WS_SSA = 149 * MiB;
constexpr size_t WS_PROJ = 152 * MiB;
constexpr size_t WS_ATT = 368 * MiB;
constexpr size_t WS_HID = 152 * MiB;
constexpr size_t WS_END = 464 * MiB;
static_assert(WS_W + DEPTH * W_LAYER_B <= 48 * MiB && WS_XB + (size_t)(MP + 300) * D * 2 <= WS_SSX && WS_SSX + (size_t)M * 64 <= WS_SSA && WS_SSA + (size_t)M * 64 <= WS_PROJ, "ws map");
static_assert(WS_PROJ + (size_t)M * NIN * 2 <= WS_ATT && WS_ATT + (size_t)M * D * 2 <= WS_END && WS_HID + (size_t)M * DFF * 2 <= WS_END, "ws map");
constexpr int CW_BAR = 1024;
constexpr int CW_CNT = 4608;
constexpr size_t WS_CONV = 47 * MiB + 800 * 1024;
constexpr size_t WS_XSLOT = 47 * MiB;
#ifndef FUSE_FINAL
#define FUSE_FINAL 1
#endif

constexpr int RING_BYTES = 131072;
constexpr int MISC_OFF = RING_BYTES;
constexpr int TAB_OFF = RING_BYTES + 1024;
constexpr int TAB_BYTES = 26 * 1024;
constexpr int LDS_BYTES = TAB_OFF + TAB_BYTES;
constexpr int NWAVES = 8;

__device__ __forceinline__ unsigned cvtpk(float lo, float hi) { f32x2 v = {lo, hi}; bf16x2_t b = __builtin_convertvector(v, bf16x2_t); return __builtin_bit_cast(unsigned, b); }
__device__ __forceinline__ float wave_sum(float v) {
#pragma unroll
    for (int o = 1; o < 64; o <<= 1) v += __shfl_xor(v, o);
    return v;
}
__device__ __forceinline__ float dpp_shr1(float x) { return __int_as_float(__builtin_amdgcn_update_dpp(0, __float_as_int(x), 0x111, 0xf, 0xf, true)); }
__device__ __forceinline__ float dpp_shl1(float x) { return __int_as_float(__builtin_amdgcn_update_dpp(0, __float_as_int(x), 0x101, 0xf, 0xf, true)); }
__device__ __forceinline__ float swap_max(float v) { auto rr = __builtin_amdgcn_permlane32_swap(__float_as_uint(v), __float_as_uint(v), false, false); return fmaxf(__uint_as_float(rr[0]), __uint_as_float(rr[1])); }
__device__ __forceinline__ float swap_sum(float v) { auto rr = __builtin_amdgcn_permlane32_swap(__float_as_uint(v), __float_as_uint(v), false, false); return __uint_as_float(rr[0]) + __uint_as_float(rr[1]); }
__device__ __forceinline__ float sum_x16_x32(float v) {
    auto a = __builtin_amdgcn_permlane16_swap(__float_as_uint(v), __float_as_uint(v), false, false); v = __uint_as_float(a[0]) + __uint_as_float(a[1]);
    auto b = __builtin_amdgcn_permlane32_swap(__float_as_uint(v), __float_as_uint(v), false, false); return __uint_as_float(b[0]) + __uint_as_float(b[1]); }
#define LDS_WAIT() asm volatile("s_waitcnt lgkmcnt(0)" ::: "memory")
__device__ __forceinline__ void glds16(const void* gsrc, unsigned lds_dst) { unsigned keep;
    asm volatile("s_mov_b32 %0, m0\n\ts_mov_b32 m0, %2\n\ts_nop 0\n\tglobal_load_lds_dwordx4 %1, off\n\ts_mov_b32 m0, %0" : "=&s"(keep) : "v"(gsrc), "s"(lds_dst) : "memory"); }
__device__ __forceinline__ void glds16s(unsigned voff, const void* sbase, unsigned lds_dst) { unsigned keep;
    asm volatile("s_mov_b32 %0, m0\n\ts_mov_b32 m0, %3\n\ts_nop 0\n\tglobal_load_lds_dwordx4 %1, %2\n\ts_mov_b32 m0, %0" : "=&s"(keep) : "v"(voff), "s"(sbase), "s"(lds_dst) : "memory"); }
__device__ __forceinline__ int lane_now() { int l; asm volatile("v_mbcnt_lo_u32_b32 %0, -1, 0\n\tv_mbcnt_hi_u32_b32 %0, -1, %0" : "=v"(l)); return l; }
__device__ __forceinline__ void glds16s2(unsigned voff0, unsigned voff1, const void* sbase, unsigned lds_dst) {
    asm volatile("s_mov_b32 m0, %3\n\ts_nop 0\n\tglobal_load_lds_dwordx4 %0, %2\n\ts_add_u32 m0, m0, 0x2000\n\ts_nop 0\n\tglobal_load_lds_dwordx4 %1, %2"
                 :: "v"(voff0), "v"(voff1), "s"(sbase), "s"(lds_dst) : "m0", "scc", "memory"); }
__device__ __forceinline__ void glds16kv(unsigned voffk, unsigned voffv, const void* sk, const void* sv, unsigned lds_dst) {
    asm volatile("s_mov_b32 m0, %4\n\ts_nop 0\n\tglobal_load_lds_dwordx4 %0, %2\n\ts_add_u32 m0, m0, 0x2000\n\ts_nop 0\n\tglobal_load_lds_dwordx4 %1, %3"
                 :: "v"(voffk), "v"(voffv), "s"(sk), "s"(sv), "s"(lds_dst) : "m0", "scc", "memory"); }
#define VM_WAIT() asm volatile("s_waitcnt vmcnt(0)" ::: "memory")

namespace pg8 {
constexpr int BM = 256, BK = 64, HALF = 128, HTB = HALF * BK * 2, NXCD = 8, WGM = 8;
__host__ __device__ __forceinline__ int lds_byte(int r, int c) { const int st = (r >> 4) * 2 + (c >> 5), rr = r & 15, cc = c & 31, ob = rr * 64 + cc * 2; return st * 1024 + (ob ^ (((ob >> 9) & 1) << 5)); }
__host__ __device__ __forceinline__ void stage_rc(int b, int& R, int& C) { const int st = b / 1024, sb = b % 1024, swz = sb ^ (((sb >> 9) & 1) << 5); R = (st >> 1) * 16 + swz / 64; C = (st & 1) * 32 + (swz % 64) / 2; }
__host__ __device__ __forceinline__ int perm32(int rho) { const int n = rho >> 4, i = rho & 15; return 8 * (i >> 2) + 4 * n + (i & 3); }

struct Unit { int pm, pn; };
struct Gemm { const char* A; const char* Bt; int K; long a_tstep, a_hstep, b_tstep, b_hstep; int amap; long a_pad; };

struct StaticOrder {
    int nM, nN, nwg, G, c, wgm, rev;
    __device__ void init(int nM_, int nN_, int G_, int c_, int wgm_ = WGM, int rev_ = 0) { nM = nM_; nN = nN_; nwg = nM * nN; G = G_; c = c_; wgm = wgm_; rev = rev_; }
    __device__ bool next(int i, Unit& u) const {
        const long L = (long)i * G + c; if (L >= nwg) return false;
        int wgid = (int)L; { const int q = nwg / NXCD, r = nwg % NXCD, xcd = wgid % NXCD, off = wgid / NXCD; wgid = (xcd < r ? xcd * (q + 1) : r * (q + 1) + (xcd - r) * q) + off; }
        const int nig = wgm * nN, gid = wgid / nig, fm = gid * wgm, gsz = (nM - fm) < wgm ? (nM - fm) : wgm;
        u.pm = fm + ((wgid % nig) % gsz); u.pn = (wgid % nig) / gsz; if (rev) u.pm = nM - 1 - u.pm; return true;
    }
};

struct NoPre { __device__ __forceinline__ void operator()() const {} };
template <class Epi, bool ALIGN_EPI, bool EARLY_DRAIN = true, class Pre = NoPre>
__device__ __forceinline__ void gemm_phase(LAS unsigned char* lds, const Gemm g, const StaticOrder& S, const Epi& E, int wv, const Pre& pre = Pre()) {
    int tid_ = wv * 64 + lane_now(); asm volatile("" : "+v"(tid_));
    const int tid = tid_, wid = __builtin_amdgcn_readfirstlane(tid >> 6), lane = tid & 63, wr = wid >> 2, wc = wid & 3, fr = lane & 15, fq = lane >> 4;
    const int K = g.K, nt = K / BK;
    unsigned voffA[2], voffB[2];
#pragma unroll
    for (int i = 0; i < 2; ++i) { int R, C; stage_rc(tid * 16 + i * 8192, R, C); const int Rb = (R & ~31) + perm32(R & 31);
        const int Ra = g.amap ? (126 * (R >> 6) + 8 * (R & 15) + ((R >> 4) & 3)) : R;
        voffA[i] = (unsigned)(Ra * K + C) * 2u; voffB[i] = (unsigned)(Rb * K + C) * 2u; }
    const size_t kstep = (size_t)(BK * 2);
    const size_t ahs = (size_t)g.a_hstep, bhs = (size_t)g.b_hstep;
    const unsigned ldsw = (unsigned)wid * 1024u; const unsigned ldsn = (unsigned)(uintptr_t)lds + ldsw;
    const int aoff = lds_byte(wr * 64 + fr, fq * 8), boff = lds_byte(wc * 32 + fr, fq * 8);
#define PG8_SA(b, h) (((b) * 2 + (h)) * HTB)
#define PG8_SB(b, h) ((4 + (b) * 2 + (h)) * HTB)
#define PG8_STAGE(bufoff, gbase, voff) glds16s2((voff)[0], (voff)[1], (const void*)(gbase), ldsn + (unsigned)(bufoff))
#define PG8_LDA(dst, b, h) do { _Pragma("unroll") for (int m = 0; m < 4; ++m) _Pragma("unroll") for (int k = 0; k < 2; ++k) dst[m][k] = *(const LAS bf16x8*)(lds + PG8_SA(b, h) + aoff + m * 2048 + k * 1024); } while (0)
#define PG8_LDB(dst, b, h) do { _Pragma("unroll") for (int n = 0; n < 2; ++n) _Pragma("unroll") for (int k = 0; k < 2; ++k) dst[n][k] = *(const LAS bf16x8*)(lds + PG8_SB(b, h) + boff + n * 2048 + k * 1024); } while (0)
#define PG8_MMA(ai, bj, At, Bt) do { __builtin_amdgcn_s_setprio(1); _Pragma("unroll") for (int m = 0; m < 4; ++m) _Pragma("unroll") for (int n = 0; n < 2; ++n) _Pragma("unroll") for (int k = 0; k < 2; ++k) \
        acc[ai][bj][m][n] = __builtin_amdgcn_mfma_f32_16x16x32_bf16(Bt[n][k], At[m][k], acc[ai][bj][m][n], 0, 0, 0); __builtin_amdgcn_s_setprio(0); } while (0)
#define PG8_WAIT_V(n) asm volatile("s_waitcnt vmcnt(" #n ")" ::: "memory")
#define PG8_WAIT_V8_UNLESS(f) asm volatile("s_cmp_lg_u32 %0, 0\n\ts_cbranch_scc1 .Lpg8w%=\n\ts_waitcnt vmcnt(8)\n.Lpg8w%=:" :: "s"(f) : "scc", "memory")
#define PG8_WAIT_L(n) asm volatile("s_waitcnt lgkmcnt(" #n ")" ::: "memory")
#define PG8_BAR __builtin_amdgcn_s_barrier()
#define PG8_SCHED __builtin_amdgcn_sched_barrier(0)
    Unit cur, nxt; int ui = 0; bool fresh = false;
    if (!S.next(0, cur)) return;
    f32x4 acc[2][2][4][2];
#pragma unroll
    for (int a = 0; a < 2; ++a)
#pragma unroll
        for (int b = 0; b < 2; ++b)
#pragma unroll
            for (int m = 0; m < 4; ++m)
#pragma unroll
                for (int n = 0; n < 2; ++n) acc[a][b][m][n] = (f32x4){0.f, 0.f, 0.f, 0.f};
    bf16x8 At[4][2], B0[2][2], B1[2][2];
    const char* cA = g.A + (size_t)cur.pm * g.a_tstep + (size_t)(cur.pm >> 6) * g.a_pad; const char* cB = g.Bt + (size_t)cur.pn * g.b_tstep;
    if constexpr (Epi::HOOK) E.unit_start(cur, ui, wid, lane);
    PG8_STAGE(PG8_SB(0, 0), cB, voffB); PG8_STAGE(PG8_SB(0, 1), cB + bhs, voffB); PG8_STAGE(PG8_SA(0, 0), cA, voffA); PG8_STAGE(PG8_SA(0, 1), cA + ahs, voffA);
    pre();
    if (wr == 1) PG8_BAR;
    PG8_WAIT_V(2); PG8_BAR;
    PG8_STAGE(PG8_SB(1, 0), cB + kstep, voffB); PG8_STAGE(PG8_SA(1, 0), cA + kstep, voffA); PG8_STAGE(PG8_SB(1, 1), cB + bhs + kstep, voffB);
    PG8_WAIT_V(6); PG8_BAR;
    for (;;) {
        const bool has_next = S.next(ui + 1, nxt);
        const char* nA = has_next ? g.A + (size_t)nxt.pm * g.a_tstep + (size_t)(nxt.pm >> 6) * g.a_pad : cA; const char* nB = has_next ? g.Bt + (size_t)nxt.pn * g.b_tstep : cB;
        int landed_flag = fresh ? 1 : 0;
        for (int th = 0; th < nt; th += (Epi::MIDK ? nt / 2 : nt)) {
        if constexpr (Epi::MIDK) { if (th) E.midk(acc, ui, wr, fr); }
        for (int t = th; t < th + (Epi::MIDK ? nt / 2 : nt); t += 2) {
            const bool last = (t == nt - 2);
            const char* a1 = cA + (size_t)(t + 1) * kstep;
            const char* a2 = last ? nA : cA + (size_t)(t + 2) * kstep; const char* b2 = last ? nB : cB + (size_t)(t + 2) * kstep;
            const char* a3 = a2 + kstep; const char* b3 = b2 + kstep;
            int lf_ = EARLY_DRAIN ? __builtin_amdgcn_readfirstlane(landed_flag) : landed_flag; if constexpr (EARLY_DRAIN) asm volatile("" : "+s"(lf_)); landed_flag = 0;
            PG8_LDB(B0, 0, 0); PG8_LDB(B1, 0, 1); PG8_SCHED; PG8_LDA(At, 0, 0); PG8_STAGE(PG8_SA(1, 1), a1 + ahs, voffA);
            if (!lf_) PG8_WAIT_V(8);
            PG8_WAIT_L(0); PG8_BAR; PG8_MMA(0, 0, At, B0); PG8_MMA(0, 1, At, B1); PG8_BAR; PG8_SCHED;
            PG8_LDA(At, 0, 1); PG8_STAGE(PG8_SB(0, 0), b2, voffB); PG8_STAGE(PG8_SB(0, 1), b2 + bhs, voffB); PG8_STAGE(PG8_SA(0, 0), a2, voffA);
            if (!lf_) PG8_WAIT_V(8);
            PG8_WAIT_L(0); PG8_BAR; PG8_MMA(1, 0, At, B0); PG8_MMA(1, 1, At, B1); PG8_BAR; PG8_SCHED;
            PG8_LDB(B0, 1, 0); PG8_LDB(B1, 1, 1); PG8_SCHED; PG8_LDA(At, 1, 0); PG8_STAGE(PG8_SA(0, 1), a2 + ahs, voffA);
            if (!lf_) PG8_WAIT_V(8);
            PG8_WAIT_L(0); PG8_BAR; PG8_MMA(0, 0, At, B0); PG8_MMA(0, 1, At, B1); PG8_BAR; PG8_SCHED;
            PG8_LDA(At, 1, 1); PG8_STAGE(PG8_SB(1, 0), b3, voffB); PG8_STAGE(PG8_SB(1, 1), b3 + bhs, voffB); PG8_STAGE(PG8_SA(1, 0), a3, voffA);
            PG8_WAIT_V(8); PG8_WAIT_L(0); PG8_BAR; PG8_MMA(1, 0, At, B0); PG8_MMA(1, 1, At, B1); PG8_BAR; PG8_SCHED;
        }
        }
        if constexpr (ALIGN_EPI) { if (wr == 0) PG8_BAR; }
        if constexpr (EARLY_DRAIN) {
            PG8_STAGE(PG8_SA(1, 1), nA + kstep + ahs, voffA); if constexpr (!Epi::OWN_DRAIN) PG8_WAIT_V(0);
        }
        { int et_ = lane_now(); asm volatile("" : "+v"(et_)); const int efr = et_ & 15, efq = et_ >> 4;
          E(acc, cur, ui, wr, wc, efr, efq); }
        if (!has_next) break;
#pragma unroll
        for (int a = 0; a < 2; ++a)
#pragma unroll
            for (int b = 0; b < 2; ++b)
#pragma unroll
                for (int m = 0; m < 4; ++m)
#pragma unroll
                    for (int n = 0; n < 2; ++n) acc[a][b][m][n] = (f32x4){0.f, 0.f, 0.f, 0.f};
        cur = nxt; cA = nA; cB = nB; ++ui; fresh = EARLY_DRAIN;
        if constexpr (Epi::HOOK) { int ht_ = lane_now(); asm volatile("" : "+v"(ht_)); E.unit_start(cur, ui, wid, ht_); }
        if constexpr (ALIGN_EPI) { if (wr == 1) PG8_BAR; }
    }
    PG8_WAIT_V(0);
    if constexpr (!ALIGN_EPI) { if (wr == 0) PG8_BAR; }
    PG8_BAR;
#undef PG8_SA
#undef PG8_SB
#undef PG8_STAGE
#undef PG8_LDA
#undef PG8_LDB
#undef PG8_MMA
#undef PG8_WAIT_V
#undef PG8_WAIT_V8_UNLESS
#undef PG8_WAIT_L
#undef PG8_BAR
#undef PG8_SCHED
}

struct EpiProj {
    static constexpr bool MIDK = false, HOOK = false, OWN_DRAIN = false;
    bf16_t* O; const LAS float* rs;
    __device__ __forceinline__ void operator()(const f32x4 (&acc)[2][2][4][2], const Unit& u, int ui, int wr, int wc, int fr, int fq) const {
        const float sct = (u.pn < 2 || u.pn == 6 || u.pn == 7) ? C2 : 1.0f;
        const LAS float* rsu = rs + ui * 256;
#pragma unroll
        for (int ai = 0; ai < 2; ++ai)
#pragma unroll
            for (int m = 0; m < 4; ++m) { const int row = ai * HALF + wr * 64 + m * 16 + fr; const float sc = rsu[row] * sct;
                bf16_t* rowp = O + (size_t)(u.pm * BM + row) * NIN + u.pn * BM + wc * 32 + 8 * fq;
#pragma unroll
                for (int bj = 0; bj < 2; ++bj) { const f32x4 v0 = acc[ai][bj][m][0] * sc, v1 = acc[ai][bj][m][1] * sc;
                    u32x4 w; w.x = cvtpk(v0[0], v0[1]); w.y = cvtpk(v0[2], v0[3]); w.z = cvtpk(v1[0], v1[1]); w.w = cvtpk(v1[2], v1[3]);
                    *(u32x4*)(rowp + bj * HALF) = w; } }
    }
};
__device__ __forceinline__ float bf_lo(unsigned w) { return __uint_as_float(w << 16); }
__device__ __forceinline__ float bf_hi(unsigned w) { return __uint_as_float(w & 0xffff0000u); }
template <bool GRP> struct EpiRes {
    static constexpr bool MIDK = GRP, HOOK = false, OWN_DRAIN = false;
    bf16_t* xb; float* ssx; const LAS f32x2* rs2;
    __device__ __forceinline__ void midk(f32x4 (&acc)[2][2][4][2], int ui, int wr, int fr) const {
        const LAS f32x2* rsu = rs2 + ui * 256;
#pragma unroll
        for (int ai = 0; ai < 2; ++ai)
#pragma unroll
            for (int m = 0; m < 4; ++m) { const float ra = rsu[ai * HALF + wr * 64 + m * 16 + fr].x;
#pragma unroll
                for (int bj = 0; bj < 2; ++bj)
#pragma unroll
                    for (int n = 0; n < 2; ++n) acc[ai][bj][m][n] *= ra; }
    }
    __device__ __forceinline__ void operator()(const f32x4 (&acc)[2][2][4][2], const Unit& u, int ui, int wr, int wc, int fr, int fq) const {
        const int row0 = wr * 64 + fr, col0 = u.pn * BM + wc * 32 + 8 * fq;
        GAS bf16_t* xp0 = (GAS bf16_t*)xb + (size_t)(u.pm * BM + (u.pm >> 6) + row0) * D + col0;
        GAS float* sp = (GAS float*)ssx + (size_t)(u.pm * BM + row0) * 16 + u.pn * 4 + wc;
        const LAS f32x2* rsu = rs2 + ui * 256 + row0;
        u32x4 rw[2][4][2];
#pragma unroll
        for (int ai = 0; ai < 2; ++ai)
#pragma unroll
            for (int m = 0; m < 4; ++m)
#pragma unroll
                for (int bj = 0; bj < 2; ++bj) rw[ai][m][bj] = *(const GAS u32x4*)(xp0 + (size_t)(ai * HALF + m * 16) * D + bj * HALF);
        GAS bf16_t* xp = xp0;
#pragma unroll
        for (int ai = 0; ai < 2; ++ai)
#pragma unroll
            for (int m = 0; m < 4; ++m) {
                float sc = 1.0f; if constexpr (GRP) sc = rsu[ai * HALF + m * 16].y;
                float ss = 0.f;
#pragma unroll
                for (int bj = 0; bj < 2; ++bj) {
                    const u32x4 r = rw[ai][m][bj];
                    const f32x4 r0 = (f32x4){bf_lo(r.x), bf_hi(r.x), bf_lo(r.y), bf_hi(r.y)}, r1 = (f32x4){bf_lo(r.z), bf_hi(r.z), bf_lo(r.w), bf_hi(r.w)};
                    const f32x4 v0 = r0 + acc[ai][bj][m][0] * sc, v1 = r1 + acc[ai][bj][m][1] * sc;
                    u32x4 w; w.x = cvtpk(v0[0], v0[1]); w.y = cvtpk(v0[2], v0[3]); w.z = cvtpk(v1[0], v1[1]); w.w = cvtpk(v1[2], v1[3]);
                    *(GAS u32x4*)(xp + bj * HALF) = w;
                    ss += (v0[0] * v0[0] + v0[1] * v0[1]) + (v0[2] * v0[2] + v0[3] * v0[3]) + (v1[0] * v1[0] + v1[1] * v1[1]) + (v1[2] * v1[2] + v1[3] * v1[3]); }
                ss = sum_x16_x32(ss);
                if (fq == 0) *sp = ss;
                const int adv = (m == 3) ? (HALF - 48) : 16;
                xp += (size_t)adv * D; sp += adv * 16;
                asm volatile("" : "+v"(xp), "+v"(sp)); }
    }
};
struct EpiFin {
    static constexpr bool MIDK = false, HOOK = false, OWN_DRAIN = true;
    const bf16_t* xb; float* out; const float* gfin; float* xslot; unsigned* cnt; LAS unsigned char* scr;
    __device__ __forceinline__ void operator()(f32x4 (&acc)[2][2][4][2], const Unit& u, int ui, int wr, int wc, int fr, int fq) const {
        int tid_ = (wr * 4 + wc) * 64 + lane_now(); asm volatile("" : "+v"(tid_)); const int tid = tid_, lane = tid & 63;
        const int row0 = wr * 64 + fr, col0 = u.pn * BM + wc * 32 + 8 * fq;
        const GAS bf16_t* xp0 = (const GAS bf16_t*)xb + (size_t)(u.pm * BM + (u.pm >> 6) + row0) * D + col0;
        LAS float* P = (LAS float*)scr; LAS float* S = (LAS float*)(scr + 4096); volatile LAS unsigned* flag = (volatile LAS unsigned*)(scr + 5120);
        u32x4 rw[2][4][2];
#pragma unroll
        for (int ai = 0; ai < 2; ++ai)
#pragma unroll
            for (int m = 0; m < 4; ++m)
#pragma unroll
                for (int bj = 0; bj < 2; ++bj) rw[ai][m][bj] = *(const GAS u32x4*)(xp0 + (size_t)(ai * HALF + m * 16) * D + bj * HALF);
#pragma unroll
        for (int ai = 0; ai < 2; ++ai)
#pragma unroll
            for (int m = 0; m < 4; ++m) { float ss = 0.f;
#pragma unroll
                for (int bj = 0; bj < 2; ++bj) { const u32x4 r = rw[ai][m][bj];
                    acc[ai][bj][m][0] += (f32x4){bf_lo(r.x), bf_hi(r.x), bf_lo(r.y), bf_hi(r.y)}; acc[ai][bj][m][1] += (f32x4){bf_lo(r.z), bf_hi(r.z), bf_lo(r.w), bf_hi(r.w)};
                    const f32x4 v0 = acc[ai][bj][m][0], v1 = acc[ai][bj][m][1];
                    ss += (v0[0] * v0[0] + v0[1] * v0[1]) + (v0[2] * v0[2] + v0[3] * v0[3]) + (v1[0] * v1[0] + v1[1] * v1[1]) + (v1[2] * v1[2] + v1[3] * v1[3]); }
                ss = sum_x16_x32(ss);
                if (fq == 0) P[(ai * HALF + row0 + m * 16) * 4 + wc] = ss; }
        asm volatile("s_waitcnt lgkmcnt(0)" ::: "memory"); __builtin_amdgcn_s_barrier(); asm volatile("" ::: "memory");
        GAS float* slot = (GAS float*)xslot + ((size_t)u.pm * 256) * 4;
        if (tid < 256) { const f32x4 p = *(const LAS f32x4*)(P + tid * 4);
            __hip_atomic_store(slot + tid * 4 + u.pn, (p[0] + p[1]) + (p[2] + p[3]), __ATOMIC_RELAXED, __HIP_MEMORY_SCOPE_AGENT); }
        asm volatile("s_waitcnt vmcnt(0)" ::: "memory"); __builtin_amdgcn_s_barrier(); asm volatile("" ::: "memory");
        if (tid == 0) {
            __hip_atomic_fetch_add(cnt + 64 * u.pm, 1u, __ATOMIC_RELAXED, __HIP_MEMORY_SCOPE_AGENT);
            unsigned sp = 0, ok = 1;
            while (__hip_atomic_load(cnt + 64 * u.pm, __ATOMIC_RELAXED, __HIP_MEMORY_SCOPE_AGENT) < 4u) { __builtin_amdgcn_s_sleep(2); if (++sp > (1u << 22)) { ok = 0; break; } }
            __builtin_amdgcn_fence(__ATOMIC_ACQUIRE, "agent");
            flag[0] = ok;
        }
        asm volatile("s_waitcnt vmcnt(0) lgkmcnt(0)" ::: "memory"); __builtin_amdgcn_s_barrier(); asm volatile("" ::: "memory");
        if (tid < 256) { float t = 0.f;
#pragma unroll
            for (int k = 0; k < 4; ++k) t += __hip_atomic_load(slot + tid * 4 + k, __ATOMIC_RELAXED, __HIP_MEMORY_SCOPE_AGENT);
            S[tid] = (flag[0] != 0u) ? 1.0f / sqrtf(t * (1.0f / D) + EPS) : __builtin_nanf(""); }
        asm volatile("s_waitcnt vmcnt(0) lgkmcnt(0)" ::: "memory"); __builtin_amdgcn_s_barrier(); asm volatile("" ::: "memory");
        f32x4 g0[2], g1[2];
#pragma unroll
        for (int bj = 0; bj < 2; ++bj) { g0[bj] = *(const GAS f32x4*)((const GAS float*)gfin + col0 + bj * HALF); g1[bj] = *(const GAS f32x4*)((const GAS float*)gfin + col0 + bj * HALF + 4); }
        GAS float* op = (GAS float*)out + (size_t)(u.pm * BM + row0) * D + col0;
#pragma unroll
        for (int ai = 0; ai < 2; ++ai)
#pragma unroll
            for (int m = 0; m < 4; ++m) { const float iv = S[ai * HALF + row0 + m * 16];
#pragma unroll
                for (int bj = 0; bj < 2; ++bj) { *(GAS f32x4*)(op + bj * HALF) = acc[ai][bj][m][0] * iv * g0[bj]; *(GAS f32x4*)(op + bj * HALF + 4) = acc[ai][bj][m][1] * iv * g1[bj]; }
                const int adv = (m == 3) ? (HALF - 48) : 16; op += (size_t)adv * D; asm volatile("" : "+v"(op)); }
        asm volatile("s_waitcnt lgkmcnt(0)" ::: "memory"); __builtin_amdgcn_s_barrier(); asm volatile("" ::: "memory");
        (void)lane;
    }
};
struct EpiUp {
    static constexpr bool MIDK = false, HOOK = true, OWN_DRAIN = true;
    bf16_t* hid; const float* cws; const LAS float* rs; LAS unsigned char* cbuf;
    __device__ __forceinline__ void unit_start(const Unit& u, int ui, int wid, int lane) const {
        if (wid < 4) { const int a = 2 * wid + (lane >> 5);
            const float* src = cws + (size_t)(a & 3) * NUP + (a >= 4 ? DFF : 0) + u.pn * HALF + (lane & 31) * 4;
            glds16(src, (unsigned)__builtin_amdgcn_readfirstlane((unsigned)(uintptr_t)cbuf + (unsigned)((ui & 1) * 4096 + wid * 1024))); }
    }
    __device__ __forceinline__ void operator()(const f32x4 (&acc)[2][2][4][2], const Unit& u, int ui, int wr, int wc, int fr, int fq) const {
        const LAS float* rsu = rs + ui * 256 + wr * 64 + fr;
        float inv[8];
#pragma unroll
        for (int q = 0; q < 8; ++q) inv[q] = rsu[(q >> 2) * HALF + (q & 3) * 16];
        const int p0 = UPM * u.pm - 1 + 126 * wr + 8 * fr;
        const int cg = u.pn * HALF + wc * 32 + 8 * fq;
#pragma unroll
        for (int h = 0; h < 2; ++h) {
            unsigned pk[2][4][2];
#pragma unroll
            for (int n = 0; n < 2; ++n) {
                const LAS float* wl = (const LAS float*)(cbuf + (ui & 1) * 4096) + wc * 32 + 8 * fq + 4 * n;
#pragma unroll
                for (int ep = 0; ep < 2; ++ep) {
                    const LAS float* wp = wl + 2 * ep;
                    const f32x2 w0g = *(const LAS f32x2*)(wp), w1g = *(const LAS f32x2*)(wp + 128), w2g = *(const LAS f32x2*)(wp + 256), bg = *(const LAS f32x2*)(wp + 384);
                    const f32x2 w0v = *(const LAS f32x2*)(wp + 512), w1v = *(const LAS f32x2*)(wp + 640), w2v = *(const LAS f32x2*)(wp + 768), bv = *(const LAS f32x2*)(wp + 896);
                    float rr[2][4];
#pragma unroll
                    for (int e2 = 0; e2 < 2; ++e2) { const int e = 2 * ep + e2;
                        float xg[6], xv[6];
#pragma unroll
                        for (int i = 1; i < 5; ++i) { xg[i] = acc[h][0][i - 1][n][e] * inv[4 * h + i - 1]; xv[i] = acc[h][1][i - 1][n][e] * inv[4 * h + i - 1]; }
                        if (h == 0) { xg[0] = dpp_shr1(acc[1][0][3][n][e] * inv[7]); xv[0] = dpp_shr1(acc[1][1][3][n][e] * inv[7]); xg[5] = acc[1][0][0][n][e] * inv[4]; xv[5] = acc[1][1][0][n][e] * inv[4]; }
                        else        { xg[0] = acc[0][0][3][n][e] * inv[3]; xv[0] = acc[0][1][3][n][e] * inv[3]; xg[5] = dpp_shl1(acc[0][0][0][n][e] * inv[0]); xv[5] = dpp_shl1(acc[0][1][0][n][e] * inv[0]); }
#pragma unroll
                        for (int i = 1; i < 5; ++i) {
                            const float gc = __builtin_fmaf(w0g[e2], xg[i - 1], __builtin_fmaf(w1g[e2], xg[i], __builtin_fmaf(w2g[e2], xg[i + 1], bg[e2])));
                            const float vc = __builtin_fmaf(w0v[e2], xv[i - 1], __builtin_fmaf(w1v[e2], xv[i], __builtin_fmaf(w2v[e2], xv[i + 1], bv[e2])));
                            const float sg = gc * __builtin_amdgcn_rcpf(1.0f + __builtin_amdgcn_exp2f(gc));
                            rr[e2][i - 1] = sg * vc; }
                    }
#pragma unroll
                    for (int i = 0; i < 4; ++i) pk[n][i][ep] = cvtpk(rr[0][i], rr[1][i]);
                    __builtin_amdgcn_sched_barrier(0);
                }
            }
            if (h == 0) asm volatile("s_waitcnt vmcnt(0)" ::: "memory");
#pragma unroll
            for (int i = 0; i < 4; ++i) { const int q = 4 * h + i; const int j = 8 * fr + q; int p = p0 + q; asm volatile("" : "+v"(p));
                const int tok = p - (p > SEQ ? 1 : 0) - (p > 2 * SEQ + 1 ? 1 : 0);
                if (j >= 1 && j <= 126 && p < MP && p != SEQ && p != 2 * SEQ + 1) { u32x4 w; w.x = pk[0][i][0]; w.y = pk[0][i][1]; w.z = pk[1][i][0]; w.w = pk[1][i][1]; *(GAS u32x4*)((GAS bf16_t*)hid + (size_t)tok * DFF + cg) = w; } }
            __builtin_amdgcn_sched_barrier(0);
        }
    }
};
}

namespace att {
constexpr int PITCH = NIN * 2;
constexpr int SLOT = 16384;
__device__ __forceinline__ float vmax2(float a, float b) { return __builtin_elementwise_maximum(a, b); }
__device__ __forceinline__ float vmax3(float a, float b, float c) { return __builtin_elementwise_maximum(__builtin_elementwise_maximum(a, b), c); }
__device__ __forceinline__ float quad_max3(float m, float v) {
    auto a = __builtin_amdgcn_permlane16_swap(__float_as_uint(v), __float_as_uint(v), false, false); v = vmax2(__uint_as_float(a[0]), __uint_as_float(a[1]));
    auto b = __builtin_amdgcn_permlane32_swap(__float_as_uint(v), __float_as_uint(v), false, false); return vmax3(m, __uint_as_float(b[0]), __uint_as_float(b[1])); }
__device__ __forceinline__ float quad_sum(float v) {
    auto a = __builtin_amdgcn_permlane16_swap(__float_as_uint(v), __float_as_uint(v), false, false); v = __uint_as_float(a[0]) + __uint_as_float(a[1]);
    auto b = __builtin_amdgcn_permlane32_swap(__float_as_uint(v), __float_as_uint(v), false, false); return __uint_as_float(b[0]) + __uint_as_float(b[1]); }
#define WJ(j) ((j) == 0 ? 0 : (j) == 1 ? 8 : (j) == 2 ? 24 : 32)
template <int MODE>
__device__ __forceinline__ void block_unit(LAS unsigned char* ring, const bf16_t* proj, bf16_t* attn, float* ssa, int lane_, int wave,
                                           int ktok0, int nT, int kcol, int vcol, int act0, int actn,
                                           int qtok0, int half, int qcol, const LAS f32x4* bcp, int dr0, float slope2, float sink2, int outcol, int sscol,
                                           int& rbase, const bool pre, const char* nK, const char* nV, const bf16_t* nQ, bf16x8 (&qf)[2][2]) {
    int lane = lane_; asm volatile("" : "+v"(lane));
    const int qi = lane & 15, g = lane >> 4;
    const int rl = lane >> 3, cl = lane & 7;
    const unsigned loffk = (unsigned)((8 * wave + rl) * PITCH + ((cl ^ ((4 * (wave & 1) + (lane >> 4)) & 7)) << 4)), loffv = (unsigned)((8 * wave + rl) * PITCH + ((cl ^ (2 * (lane >> 4))) << 4));
    const char* kg = (const char*)(proj + (size_t)ktok0 * NIN + kcol);
    const char* vg = (const char*)(proj + (size_t)ktok0 * NIN + vcol);
    const unsigned ring0 = (unsigned)(uintptr_t)ring + (unsigned)wave * 1024u;
    const int base = rbase;
#define DMA_TILE(t) do { const unsigned sl_ = (unsigned)__builtin_amdgcn_readfirstlane(ring0 + (unsigned)(((t) + base) % 3) * SLOT); \
        glds16kv(loffk, loffv, kg + (size_t)(t) * 64 * PITCH, vg + (size_t)(t) * 64 * PITCH, sl_); } while (0)
#define DMA_NEXT(i) do { const unsigned sl_ = (unsigned)__builtin_amdgcn_readfirstlane(ring0 + (unsigned)((nT + (i) + base) % 3) * SLOT); \
        glds16kv(loffk, loffv, nK + (size_t)(i) * 64 * PITCH, nV + (size_t)(i) * 64 * PITCH, sl_); } while (0)
    const size_t qoff = (size_t)qi * NIN + 8 * g;
    if (!pre) { DMA_TILE(0); DMA_TILE(1);
#pragma unroll
        for (int jj = 0; jj < 2; ++jj)
#pragma unroll
            for (int ks = 0; ks < 2; ++ks) qf[jj][ks] = *(const GAS bf16x8*)((const GAS bf16_t*)proj + (size_t)(qtok0 + 16 * jj) * NIN + qcol + 32 * ks + qoff);
        __builtin_amdgcn_s_waitcnt(0x0F70);
    } else {
        __builtin_amdgcn_s_waitcnt(0x0F74);
    }
    f32x4 o[2][4];
    float mrun[2], lrun[2];
#pragma unroll
    for (int jj = 0; jj < 2; ++jj) {
#pragma unroll
        for (int dt = 0; dt < 4; ++dt) o[jj][dt] = (f32x4){0.f, 0.f, 0.f, 0.f};
        mrun[jj] = (MODE == 1) ? sink2 : -1e30f; lrun[jj] = (MODE == 1 && g == 0) ? 1.0f : 0.0f; }
    const int va = (lane & 15) >> 2, vb = lane & 3, sv = (2 * (g & 1) + (va >> 1)) & 3;
    int kofs[2], kad[2][2], vad[2], relm[2], bofs[2];
#pragma unroll
    for (int jj = 0; jj < 2; ++jj) {
        const int j = 2 * half + jj; const int koff = (MODE == 1) ? 0 : ((j == 0) ? 0 : (j == 1) ? 8 : (j == 2) ? 24 : 32);
        const int par = (koff >> 3) & 1, s0 = g ^ (qi >> 1);
        kofs[jj] = koff;
        kad[jj][0] = (koff + qi) * 128 + ((s0 ^ (4 * par)) << 4); kad[jj][1] = (koff + qi) * 128 + ((s0 ^ (4 * par) ^ 4) << 4);
        vad[jj] = 8192 + (koff + 4 * g + va) * 128 + vb * 8;
        const int c = 16 * j + qi, cs = min(max(c - 8, 0), 48);
        relm[jj] = koff + 4 * g - cs;
        const int raw = (MODE == 1) ? (ktok0 - (qtok0 + 16 * jj + qi) + 4 * g + 191) : (koff + 4 * g - c + 15 + 16); const int s4 = (3 - qi) & 3;
        bofs[jj] = s4 * ((MODE == 0) ? 968 : 768) + ((raw - s4) >> 2); }
    const float NEG = -INFINITY;
    f32x4 mneg[2][2];
#pragma unroll
    for (int jj = 0; jj < 2; ++jj)
#pragma unroll
        for (int kt = 0; kt < 2; ++kt)
#pragma unroll
            for (int e = 0; e < 4; ++e) mneg[jj][kt][e] = (MODE == 0 && !((unsigned)(relm[jj] + 16 * kt + e) < 16u)) ? NEG : 0.f;
    constexpr int NH = (MODE == 1) ? 2 : 1;
    auto head = [&](const int t) __attribute__((always_inline)) {
        if (t >= 2) { if (t + 1 < nT || nK) asm volatile("s_waitcnt vmcnt(2)" ::: "memory"); else asm volatile("s_waitcnt vmcnt(0)" ::: "memory"); }
        __builtin_amdgcn_s_barrier();
        if (t + 2 < nT) DMA_TILE(t + 2); else if (nK) DMA_NEXT(t + 2 - nT);
    };
    auto body = [&](const int t) __attribute__((always_inline)) {
        if (t >= act0 && t < act0 + actn) {
        const LAS unsigned char* Sl = ring + ((t + base) % 3) * SLOT;
#pragma unroll
        for (int hf = 0; hf < NH; ++hf) {
            if (MODE == 1) { const int ks = ktok0 + 64 * t + 32 * hf;
                if (ks + 31 < qtok0 - 128 || ks > qtok0 + 31 + 128) continue; }
            bf16x8 kf[2][2][2];
#pragma unroll
            for (int jj = 0; jj < 2; ++jj)
#pragma unroll
                for (int kt = 0; kt < 2; ++kt)
#pragma unroll
                    for (int ks = 0; ks < 2; ++ks) kf[jj][kt][ks] = *(const LAS bf16x8*)(Sl + kad[jj][ks] + (32 * hf + 16 * kt) * 128);
            f32x4 bb[2][2];
#pragma unroll
            for (int jj = 0; jj < 2; ++jj) { const LAS f32x4* bl = bcp + ((MODE == 0) ? (dr0 + t - act0) * 8 : 16 * t + 8 * hf) + bofs[jj];
#pragma unroll
                for (int kt = 0; kt < 2; ++kt) bb[jj][kt] = bl[4 * kt]; }
            s16x4 vlo[2][4], vhi[2][4];
#pragma unroll
            for (int jj = 0; jj < 2; ++jj)
#pragma unroll
                for (int dt = 0; dt < 4; ++dt) { const LAS unsigned char* vp = Sl + vad[jj] + (32 * hf) * 128 + ((dt ^ sv) << 5);
                    vlo[jj][dt] = __builtin_bit_cast(s16x4, __builtin_amdgcn_ds_read_tr16_b64_v4i16((LAS s16x4*)(vp)));
                    vhi[jj][dt] = __builtin_bit_cast(s16x4, __builtin_amdgcn_ds_read_tr16_b64_v4i16((LAS s16x4*)(vp + 2048))); }
            __builtin_amdgcn_sched_barrier(0);
            f32x4 s[2][2];
#pragma unroll
            for (int jj = 0; jj < 2; ++jj)
#pragma unroll
                for (int kt = 0; kt < 2; ++kt) { f32x4 a = (MODE == 0) ? bb[jj][kt] + mneg[jj][kt] : bb[jj][kt];
                    a = __builtin_amdgcn_mfma_f32_16x16x32_bf16(kf[jj][kt][0], qf[jj][0], a, 0, 0, 0);
                    s[jj][kt] = __builtin_amdgcn_mfma_f32_16x16x32_bf16(kf[jj][kt][1], qf[jj][1], a, 0, 0, 0); }
            u32x4 pw[2];
#pragma unroll
            for (int jj = 0; jj < 2; ++jj) {
                const float tm = vmax3(vmax3(s[jj][0][0], s[jj][0][1], s[jj][0][2]), vmax3(s[jj][0][3], s[jj][1][0], s[jj][1][1]), vmax3(s[jj][1][2], s[jj][1][3], s[jj][1][3]));
                const float mn = quad_max3(mrun[jj], tm);
                const float alpha = __builtin_amdgcn_exp2f(mrun[jj] - mn);
                mrun[jj] = mn;
                float rsum = 0.f;
#pragma unroll
                for (int kt = 0; kt < 2; ++kt)
#pragma unroll
                    for (int e = 0; e < 4; ++e) { s[jj][kt][e] = __builtin_amdgcn_exp2f(s[jj][kt][e] - mn); rsum += s[jj][kt][e]; }
                lrun[jj] = lrun[jj] * alpha + rsum;
#pragma unroll
                for (int dt = 0; dt < 4; ++dt) o[jj][dt] *= alpha;
                pw[jj].x = cvtpk(s[jj][0][0], s[jj][0][1]); pw[jj].y = cvtpk(s[jj][0][2], s[jj][0][3]); pw[jj].z = cvtpk(s[jj][1][0], s[jj][1][1]); pw[jj].w = cvtpk(s[jj][1][2], s[jj][1][3]);
            }
#pragma unroll
            for (int jj = 0; jj < 2; ++jj)
#pragma unroll
                for (int dt = 0; dt < 4; ++dt) {
                    const bf16x8 vf = (bf16x8){vlo[jj][dt][0], vlo[jj][dt][1], vlo[jj][dt][2], vlo[jj][dt][3], vhi[jj][dt][0], vhi[jj][dt][1], vhi[jj][dt][2], vhi[jj][dt][3]};
                    o[jj][dt] = __builtin_amdgcn_mfma_f32_16x16x32_bf16(vf, __builtin_bit_cast(bf16x8, pw[jj]), o[jj][dt], 0, 0, 0); }
            __builtin_amdgcn_sched_barrier(0);
        }
        }
    };
    for (int t = 0; t < nT - 1; ++t) { head(t); body(t); }
    head(nT - 1);
    bf16x8 qn[2][2];
    { const GAS bf16_t* qs = nQ ? (const GAS bf16_t*)nQ : (const GAS bf16_t*)proj + (size_t)qtok0 * NIN + qcol;
#pragma unroll
      for (int jj = 0; jj < 2; ++jj)
#pragma unroll
          for (int ks = 0; ks < 2; ++ks) qn[jj][ks] = *(const GAS bf16x8*)(qs + (size_t)(16 * jj) * NIN + 32 * ks + qoff); }
    body(nT - 1);
#undef DMA_TILE
#undef DMA_NEXT
    rbase = (base + nT) % 3;
    {
#pragma unroll
    for (int jj = 0; jj < 2; ++jj) {
        const float lt = quad_sum(lrun[jj]); const float il = 1.0f / lt;
        const int tok = qtok0 + 16 * jj + qi;
        float ss = 0.f;
        u32x2 w[4];
#pragma unroll
        for (int dt = 0; dt < 4; ++dt) { const f32x4 v = o[jj][dt] * il;
            ss += (v[0] * v[0] + v[1] * v[1]) + (v[2] * v[2] + v[3] * v[3]);
            w[dt].x = cvtpk(v[0], v[1]); w[dt].y = cvtpk(v[2], v[3]); }
#pragma unroll
        for (int pr = 0; pr < 2; ++pr) {
            auto sx = __builtin_amdgcn_permlane16_swap(w[2 * pr].x, w[2 * pr + 1].x, false, false);
            auto sy = __builtin_amdgcn_permlane16_swap(w[2 * pr].y, w[2 * pr + 1].y, false, false);
            u32x4 o4; o4.x = sx[0]; o4.y = sy[0]; o4.z = sx[1]; o4.w = sy[1];
            *(GAS u32x4*)((GAS bf16_t*)attn + (size_t)tok * D + outcol + 16 * (2 * pr + (g & 1)) + 4 * (g & 2)) = o4; }
        ss = quad_sum(ss);
        if (g == 0) ((GAS float*)ssa)[(size_t)tok * 16 + sscol] = ss;
    }
    }
#pragma unroll
    for (int jj = 0; jj < 2; ++jj)
#pragma unroll
        for (int ks = 0; ks < 2; ++ks) { qf[jj][ks] = qn[jj][ks]; asm volatile("" : "+v"(qf[jj][ks])); }
    __builtin_amdgcn_s_barrier();
}
#undef WJ
}

#define XB_TMO      128
#define XB_XCNT(j)  (256  + 64 * (j))
#define XB_XSUB(j)  (1280 + 64 * (j))
#define XB_XGEN(j)  (2304 + 64 * (j))
#define XB_TOP      3328
#define XB_TOPGEN   3392
#define XCD_BAR_WORDS 3456
#define XB_SPIN_CAP (1u << 20)
__device__ __forceinline__ unsigned xb_ld(unsigned* p)              { return __hip_atomic_load(p, __ATOMIC_RELAXED, __HIP_MEMORY_SCOPE_AGENT); }
__device__ __forceinline__ unsigned xb_add(unsigned* p, unsigned v) { return __hip_atomic_fetch_add(p, v, __ATOMIC_RELAXED, __HIP_MEMORY_SCOPE_AGENT); }
__device__ __forceinline__ unsigned xb_xcc_id() { return (unsigned)__builtin_amdgcn_s_getreg((3 << 11) | 20) & 0xFu; }
#define XB_SPIN(cond, bar) do { unsigned _sp = 0; while (cond) { __builtin_amdgcn_s_sleep(1); \
    if ((++_sp & 255u) == 0u) { if (xb_ld(&(bar)[XB_TMO])) break; if (_sp > XB_SPIN_CAP) { atomicAdd(&(bar)[XB_TMO], 1u); break; } } } } while (0)
struct XcdBarrier { unsigned* bar; unsigned x; volatile LAS unsigned* st; };
__device__ __forceinline__ XcdBarrier xcd_barrier_post(unsigned* bar, volatile LAS unsigned* st) {
    XcdBarrier b; b.bar = bar; b.x = xb_xcc_id(); b.st = st;
    if (threadIdx.x == 0) (void)xb_add(&bar[XB_XCNT(b.x)], 1u);
    return b;
}
__device__ __forceinline__ void xcd_barrier_complete(unsigned* bar, unsigned x, unsigned& nloc, unsigned& nx) {
    const unsigned G = gridDim.x * gridDim.y * gridDim.z;
    unsigned sum, cnt, mine, sp = 0u;
    for (;;) {
        sum = 0u; cnt = 0u; mine = 0u;
#pragma unroll
        for (unsigned j = 0; j < 16; ++j) { const unsigned c = xb_ld(&bar[XB_XCNT(j)]); sum += c; cnt += (c > 0u) ? 1u : 0u; mine = (j == x) ? c : mine; }
        if (sum == G) break;
        __builtin_amdgcn_s_sleep(1);
        if ((++sp & 255u) == 0u) { if (xb_ld(&bar[XB_TMO])) break; if (sp > XB_SPIN_CAP) { atomicAdd(&bar[XB_TMO], 1u); break; } }
    }
    nloc = mine > 0u ? mine : 1u; nx = cnt > 0u ? cnt : 1u;
}
__device__ __forceinline__ void xcd_barrier(const XcdBarrier& b, int wv) {
    asm volatile("s_waitcnt vmcnt(0)" ::: "memory");
    __syncthreads();
    if (wv == 0 && lane_now() == 0) {
        unsigned* bar = b.bar;
        __builtin_amdgcn_s_waitcnt(0);
        unsigned nloc = b.st[0], nx = b.st[1];
        if (nloc == 0u) { xcd_barrier_complete(bar, b.x, nloc, nx); b.st[0] = nloc; b.st[1] = nx; }
        const unsigned old = xb_add(&bar[XB_XSUB(b.x)], 1u);
        const unsigned gen = old / nloc;
        if (old + 1u == (gen + 1u) * nloc) {
            __builtin_amdgcn_fence(__ATOMIC_RELEASE, "agent");
            asm volatile("s_waitcnt vmcnt(0)" ::: "memory");
            const unsigned og = xb_add(&bar[XB_TOP], 1u);
            const unsigned tg = og / nx;
            if (og + 1u == (tg + 1u) * nx) xb_add(&bar[XB_TOPGEN], 1u);
            else XB_SPIN(xb_ld(&bar[XB_TOPGEN]) == tg, bar);
            xb_add(&bar[XB_XGEN(b.x)], 1u);
            __builtin_amdgcn_fence(__ATOMIC_ACQUIRE, "agent");
            asm volatile("s_waitcnt vmcnt(0)" ::: "memory");
        } else {
            XB_SPIN(xb_ld(&bar[XB_XGEN(b.x)]) == gen, bar);
            __builtin_amdgcn_fence(__ATOMIC_ACQUIRE, "agent");
            asm volatile("s_waitcnt vmcnt(0)" ::: "memory");
        }
    }
    __syncthreads();
}

struct Args { const float* in[14]; float* out; unsigned char* ws; int ph_lo, ph_hi, li, pad; };
constexpr int N_PHASES = 2 + 5 * DEPTH;

__device__ __forceinline__ void transpose_item(const float* W, const float* gain, int K, int N, bf16_t* WT, LAS float* scr, int item, int lane) {
    const int nblk = N / 32, kb = item / nblk, nb = item % nblk, k0 = 64 * kb, n0 = 32 * nb;
    f32x4 wv[8]; float gk[8];
#pragma unroll
    for (int i = 0; i < 8; ++i) { const int kk = (lane >> 3) + 8 * i; wv[i] = *(const GAS f32x4*)((const GAS float*)W + (size_t)(k0 + kk) * N + n0 + 4 * (lane & 7)); gk[i] = gain ? gain[k0 + kk] : 1.0f; }
#pragma unroll
    for (int i = 0; i < 8; ++i) { const int kk = (lane >> 3) + 8 * i; LAS float* d = scr + kk * 33 + 4 * (lane & 7);
        d[0] = wv[i][0] * gk[i]; d[1] = wv[i][1] * gk[i]; d[2] = wv[i][2] * gk[i]; d[3] = wv[i][3] * gk[i]; }
    LDS_WAIT(); asm volatile("" ::: "memory");
    const int c = lane & 7;
#pragma unroll
    for (int j = 0; j < 4; ++j) { const int n = (lane >> 3) + 8 * j; const LAS float* s = scr + (8 * c) * 33 + n;
        u32x4 o; o.x = cvtpk(s[0 * 33], s[1 * 33]); o.y = cvtpk(s[2 * 33], s[3 * 33]); o.z = cvtpk(s[4 * 33], s[5 * 33]); o.w = cvtpk(s[6 * 33], s[7 * 33]);
        *(u32x4*)(WT + (size_t)(n0 + n) * K + k0 + 8 * c) = o; }
    LDS_WAIT(); asm volatile("" ::: "memory");
}

__global__ void __launch_bounds__(NWAVES * 64, 2) fwd_kernel(Args args) {
    extern __shared__ __attribute__((aligned(16))) unsigned char lds_raw[];
    LAS unsigned char* lds = (LAS unsigned char*)lds_raw;
    volatile LAS unsigned* MISC = (volatile LAS unsigned*)(lds + MISC_OFF);
    const int G = gridDim.x; const int bx = blockIdx.x; const int vcu = (G % 8 == 0) ? (bx % 8) * (G / 8) + bx / 8 : bx;
    unsigned char* ws = args.ws;
    unsigned* ctl = (unsigned*)(ws + WS_CTL);
    const float* x_p = args.in[0]; const float* x_s = args.in[1];
    const float* norm_mix = args.in[2]; const float* w_in = args.in[3]; const float* rpb = args.in[4]; const float* sinks = args.in[5];
    const float* norm_grp = args.in[6]; const float* w_out = args.in[7]; const float* norm_ffn = args.in[8]; const float* w_up = args.in[9];
    const float* conv_w = args.in[10]; const float* conv_b = args.in[11]; const float* w_down = args.in[12]; const float* norm_final = args.in[13];
    float* out = args.out;
    bf16_t* XB = (bf16_t*)(ws + WS_XB); float* SSX = (float*)(ws + WS_SSX); float* SSA = (float*)(ws + WS_SSA);
    bf16_t* PROJ = (bf16_t*)(ws + WS_PROJ); bf16_t* ATT = (bf16_t*)(ws + WS_ATT); bf16_t* HID = (bf16_t*)(ws + WS_HID);

    const int wave_s = __builtin_amdgcn_readfirstlane((int)(threadIdx.x >> 6));
    for (int u = threadIdx.x; u < 256; u += NWAVES * 64) ((LAS unsigned*)(lds + MISC_OFF))[u] = 0u;
    __syncthreads();
    XcdBarrier bar; bar.bar = ctl + CW_BAR; bar.x = 0; bar.st = nullptr;
    if (MK_N_LAUNCHES == 1) bar = xcd_barrier_post(ctl + CW_BAR, MISC + 8);
    const int lo = args.ph_lo, hi_ph = args.ph_hi;
#define PHASE_IDS int tid_ = wave_s * 64 + lane_now(); asm volatile("" : "+v"(tid_) :: "memory"); const int tid = tid_, lane = tid & 63, wave = wave_s; const int gw = vcu * NWAVES + wave, NGW = G * NWAVES; (void)lane; (void)gw; (void)NGW
#ifndef PH_MASK
#define PH_MASK 0x7f
#endif
#define KIND(k) ((k) == 0 ? 0 : ((k) == N_PHASES - 1 ? 6 : 1 + ((k) - 1) % 5))
#define IN(k) (((PH_MASK >> KIND(k)) & 1) && lo <= (k) && (k) < hi_ph)
#define SEAM(k) do { if (IN(k) && IN((k) + 1)) xcd_barrier(bar, wave_s); } while (0)

    for (int rep = 0; rep <= ((REP_MASK >> 0) & 1); ++rep) if (IN(0)) {
        PHASE_IDS;
        LAS float* scr = (LAS float*)(lds + wave * 16384);
        constexpr int I_IN = (D / 64) * (NIN / 32), I_OUT = (D / 64) * (D / 32), I_UP = (D / 64) * (NUP / 32), I_DN = (DFF / 64) * (D / 32), I_L = I_IN + I_OUT + I_UP + I_DN;
        for (int it = gw; it < DEPTH * I_L; it += NGW) {
            const int l = it / I_L; int r = it % I_L;
            unsigned char* wl = ws + WS_W + (size_t)l * W_LAYER_B;
            if (r < I_IN) { transpose_item(w_in + (size_t)l * D * NIN, norm_mix + l * D, D, NIN, (bf16_t*)wl, scr, r, lane); continue; } r -= I_IN;
            if (r < I_OUT) { transpose_item(w_out + (size_t)l * D * D, norm_grp + l * D, D, D, (bf16_t*)(wl + W_IN_B), scr, r, lane); continue; } r -= I_OUT;
            if (r < I_UP) { transpose_item(w_up + (size_t)l * D * NUP, norm_ffn + l * D, D, NUP, (bf16_t*)(wl + W_IN_B + W_OUT_B), scr, r, lane); continue; } r -= I_UP;
            transpose_item(w_down + (size_t)l * DFF * D, nullptr, DFF, D, (bf16_t*)(wl + W_IN_B + W_OUT_B + W_UP_B), scr, r, lane);
        }
        for (int m0 = 4 * gw; m0 < M; m0 += 4 * NGW) {
            f32x4 v[4][4];
#pragma unroll
            for (int r = 0; r < 4; ++r) { const int m = m0 + r; const GAS float* xr = (m < SEQ) ? (const GAS float*)x_p + (size_t)m * D : (const GAS float*)x_s + (size_t)(m - SEQ) * D;
#pragma unroll
                for (int j = 0; j < 4; ++j) v[r][j] = *(const GAS f32x4*)(xr + 4 * lane + 256 * j); }
#pragma unroll
            for (int r = 0; r < 4; ++r) { const int m = m0 + r; float s = 0.f;
#pragma unroll
                for (int j = 0; j < 4; ++j) s += (v[r][j][0] * v[r][j][0] + v[r][j][1] * v[r][j][1]) + (v[r][j][2] * v[r][j][2] + v[r][j][3] * v[r][j][3]);
                s = wave_sum(s);
#pragma unroll
                for (int j = 0; j < 4; ++j) { u32x2 w; w.x = cvtpk(v[r][j][0], v[r][j][1]); w.y = cvtpk(v[r][j][2], v[r][j][3]); *(GAS u32x2*)((GAS bf16_t*)XB + (size_t)(m + m / SEQ) * D + 4 * lane + 256 * j) = w; }
                if (lane < 16) ((GAS float*)SSX)[(size_t)m * 16 + lane] = s * (1.0f / 16.0f); }
        }
        for (int i = gw * 64 + lane; i < DEPTH * 4 * NUP; i += NGW * 64) {
            const int c = i % NUP, a = (i / NUP) & 3, l2 = i / (4 * NUP);
            const float v = (a < 3) ? conv_w[((size_t)l2 * 3 + a) * NUP + c] : conv_b[(size_t)l2 * NUP + c];
            ((float*)(ws + WS_CONV))[i] = v * ((c < DFF) ? -LOG2E : -1.0f / LOG2E); }
        for (int z = gw; z < 3 + 300; z += NGW) {
            const long prow = (z == 0) ? -1 : (z == 1) ? SEQ : (z == 2) ? 2 * SEQ + 1 : (long)MP + (z - 3);
#pragma unroll
            for (int j = 0; j < 4; ++j) *(u32x2*)(XB + prow * D + 4 * lane + 256 * j) = (u32x2){0u, 0u};
        }
    }
    SEAM(0);

    for (int l = 0; l < DEPTH; ++l) {
        const int pb = 1 + 5 * l;
        const unsigned char* wl = ws + WS_W + (size_t)l * W_LAYER_B;
        const char* Win_t = (const char*)wl; const char* Wout_t = (const char*)(wl + W_IN_B); const char* Wup_t = (const char*)(wl + W_IN_B + W_OUT_B); const char* Wdn_t = (const char*)(wl + W_IN_B + W_OUT_B + W_UP_B);

        for (int rep = 0; rep <= ((REP_MASK >> 1) & 1); ++rep) if (IN(pb)) {
            PHASE_IDS;
            pg8::StaticOrder S; S.init(M / 256, NIN / 256, G, bx);
            LAS float* tab = (LAS float*)(lds + TAB_OFF);
            auto pre = [&]() __attribute__((always_inline))
            { pg8::Unit u; for (int i = wave >> 2; S.next(i, u); i += 2)       { const int row = tid & 255; const float* p = SSX + (size_t)(u.pm * 256 + row) * 16;
                const f32x4 a = *(const f32x4*)p, b = *(const f32x4*)(p + 4), c = *(const f32x4*)(p + 8), d = *(const f32x4*)(p + 12);
                const float s = ((a[0] + a[1]) + (a[2] + a[3])) + ((b[0] + b[1]) + (b[2] + b[3])) + ((c[0] + c[1]) + (c[2] + c[3])) + ((d[0] + d[1]) + (d[2] + d[3]));
                tab[i * 256 + row] = 1.0f / sqrtf(s * (1.0f / D) + EPS); } }
            ;
            pg8::Gemm g{(const char*)XB, Win_t, D, 256L * D * 2, 128L * D * 2, 256L * D * 2, 128L * D * 2, 0, (long)D * 2};
            pg8::EpiProj E{PROJ, tab};
            pg8::gemm_phase<pg8::EpiProj, true, true, decltype(pre)>(lds, g, S, E, wave, pre);
        }
        SEAM(pb);

        for (int rep = 0; rep <= ((REP_MASK >> 2) & 1); ++rep) if (IN(pb + 1)) {
            PHASE_IDS;
            LAS float* tab = (LAS float*)(lds + TAB_OFF);
            for (int i = tid; i < 8 * 15 * 32; i += NWAVES * 64) { const int h = i / 480, rem = i % 480, dr = rem >> 5, o = rem & 31;
                tab[i] = (o < 31) ? rpb[((size_t)(l * 8 + h) * 15 + dr) * 31 + o] * LOG2E : 0.f; }
            if (tid < 16) tab[8 * 15 * 32 + tid] = 0.f;
            __syncthreads();
            LAS f32x4* cpy = (LAS f32x4*)(lds + 65536);
            for (int i = tid; i < 4 * 968; i += NWAVES * 64) { const int sft = i / 968, k = i % 968; f32x4 v;
#pragma unroll
                for (int e = 0; e < 4; ++e) { const int x = 4 * k + sft + e - 16; v[e] = (x >= 0 && x < 8 * 15 * 32 + 16) ? tab[min(max(x, 0), 8 * 15 * 32 + 15)] : 0.f; }
                cpy[i] = v; }
            __syncthreads();
            int rbase = 0; bool pre = false; bf16x8 qf[2][2] = {};
            auto kbase_n = [&](int n, const char*& K0, const char*& V0) __attribute__((always_inline)) { const int r4 = n & 63, h = (n >> 6) & 7, sq = n >> 9; const int rs0 = min(max(4 * r4 - 4, 0), 248);
                const bf16_t* b = PROJ + (size_t)(sq * SEQ + rs0 * 64) * NIN; K0 = (const char*)(b + COL_KA + h * 64); V0 = (const char*)(b + COL_VA + h * 64); };
            auto kbase_s = [&](int n, const char*& K0, const char*& V0) __attribute__((always_inline)) { const int tt = n & 255, kvh = (n >> 8) & 1, sq = n >> 9; const int u_lo = max(64 * tt - 128, 0);
                const bf16_t* b = PROJ + (size_t)(sq * SEQ + u_lo) * NIN; K0 = (const char*)(b + COL_KB + kvh * 64); V0 = (const char*)(b + COL_VB + kvh * 64); };
            for (int rp = 0; rp <= ((REP_MASK >> 8) & 1); ++rp)
            for (int n = vcu; n < 1536; n += G) {
                const int r4 = n & 63, h = (n >> 6) & 7, sq = n >> 9; const int r0 = 4 * r4, r = r0 + (wave >> 1);
                const int rs0 = min(max(r0 - 4, 0), 248), rs3 = min(max(r0 - 1, 0), 248), rs = min(max(r - 4, 0), 248);
                const char* nK = nullptr; const char* nV = nullptr;
                const bf16_t* nQ = nullptr;
                if (n + G < 1536) { kbase_n(n + G, nK, nV); const int n2 = n + G; nQ = PROJ + (size_t)((n2 >> 9) * SEQ + (4 * (n2 & 63) + (wave >> 1)) * 64 + 32 * (wave & 1)) * NIN + COL_QA + ((n2 >> 6) & 7) * 64; }
                else if (REP_MASK == 0 && vcu < 1536) { kbase_s(vcu, nK, nV); const int n2 = vcu; nQ = PROJ + (size_t)((n2 >> 9) * SEQ + 64 * (n2 & 255) + 32 * (wave >> 2)) * NIN + COL_QB + (4 * ((n2 >> 8) & 1) + (wave & 3)) * 64; }
                att::block_unit<0>(lds, PROJ, ATT, SSA, lane, wave, sq * SEQ + rs0 * 64, rs3 + 8 - rs0, COL_KA + h * 64, COL_VA + h * 64, rs - rs0, 8,
                                   sq * SEQ + r * 64 + 32 * (wave & 1), wave & 1, COL_QA + h * 64, cpy + h * 120, rs - r + 7, 0.f, 0.f, h * 64, h, rbase, pre, nK, nV, nQ, qf);
                pre = (nK != nullptr);
            }
            __syncthreads();
            for (int i = tid; i < 8 * 384; i += NWAVES * 64) { const int h = i / 384, dd = abs(i % 384 - 191);
                tab[i] = (dd <= 128) ? -__builtin_amdgcn_exp2f(-(float)(h + 1)) * LOG2E * (float)dd : -INFINITY; }
            __syncthreads();
            for (int i = tid; i < 4 * 768; i += NWAVES * 64) { const int sft = i / 768, k = i % 768; f32x4 v;
#pragma unroll
                for (int e = 0; e < 4; ++e) { const int x = 4 * k + sft + e; v[e] = (x < 8 * 384) ? tab[min(x, 8 * 384 - 1)] : -INFINITY; }
                cpy[i] = v; }
            __syncthreads();
            float sinkA = sinks[l * 8 + (wave & 3)] * LOG2E, sinkB = sinks[l * 8 + 4 + (wave & 3)] * LOG2E;
            __builtin_amdgcn_s_waitcnt(0x0F70); asm volatile("" : "+v"(sinkA), "+v"(sinkB));
            for (int rp = 0; rp <= ((REP_MASK >> 9) & 1); ++rp)
            for (int n = vcu; n < 1536; n += G) {
                const int tt = n & 255, kvh = (n >> 8) & 1, sq = n >> 9; const int hb = 4 * kvh + (wave & 3), t0 = 64 * tt;
                const int u_lo = max(t0 - 128, 0), u_hi = min(t0 + 192, SEQ);
                const float slope2 = __builtin_amdgcn_exp2f(-(float)(hb + 1)) * LOG2E; const float sink2 = kvh ? sinkB : sinkA;
                const char* nK = nullptr; const char* nV = nullptr;
                const bf16_t* nQ = nullptr;
                if (n + G < 1536) { kbase_s(n + G, nK, nV); const int n2 = n + G; nQ = PROJ + (size_t)((n2 >> 9) * SEQ + 64 * (n2 & 255) + 32 * (wave >> 2)) * NIN + COL_QB + (4 * ((n2 >> 8) & 1) + (wave & 3)) * 64; }
                att::block_unit<1>(lds, PROJ, ATT, SSA, lane, wave, sq * SEQ + u_lo, (u_hi - u_lo) >> 6, COL_KB + kvh * 64, COL_VB + kvh * 64, 0, (u_hi - u_lo) >> 6,
                                   sq * SEQ + t0 + 32 * (wave >> 2), wave >> 2, COL_QB + hb * 64, cpy + hb * 96, 0, slope2, sink2, 512 + hb * 64, 8 + hb, rbase, pre, nK, nV, nQ, qf);
                pre = (nK != nullptr);
            }
            __syncthreads();
        }
        SEAM(pb + 1);

        if (IN(pb + 2)) {
            PHASE_IDS;
            pg8::StaticOrder S; S.init(M / 256, D / 256, G, bx);
            LAS f32x2* tab = (LAS f32x2*)(lds + TAB_OFF);
            auto pre = [&]() __attribute__((always_inline))
            { pg8::Unit u; for (int i = wave >> 2; S.next(i, u); i += 2)       { const int row = tid & 255; const float* p = SSA + (size_t)(u.pm * 256 + row) * 16;
                const f32x4 a = *(const f32x4*)p, b = *(const f32x4*)(p + 4), c = *(const f32x4*)(p + 8), d = *(const f32x4*)(p + 12);
                const float sa = ((a[0] + a[1]) + (a[2] + a[3])) + ((b[0] + b[1]) + (b[2] + b[3])), sb = ((c[0] + c[1]) + (c[2] + c[3])) + ((d[0] + d[1]) + (d[2] + d[3]));
                const float ia = 1.0f / sqrtf(sa * (1.0f / 512.f) + EPS), ib = 1.0f / sqrtf(sb * (1.0f / 512.f) + EPS);
                tab[i * 256 + row] = (f32x2){ia / ib, ib}; } }
            ;
            pg8::Gemm g{(const char*)ATT, Wout_t, D, 256L * D * 2, 128L * D * 2, 256L * D * 2, 128L * D * 2, 0, 0L};
            pg8::EpiRes<true> E{XB, SSX, tab};
            pg8::gemm_phase<pg8::EpiRes<true>, true, false, decltype(pre)>(lds, g, S, E, wave, pre);
        }
        SEAM(pb + 2);

        for (int rep = 0; rep <= ((REP_MASK >> 4) & 1); ++rep) if (IN(pb + 3)) {
            PHASE_IDS;
            pg8::StaticOrder S; S.init(UP_NM, DFF / 128, G, bx, UP_WGM);
            LAS float* tab = (LAS float*)(lds + TAB_OFF);
            { pg8::Unit u; for (int i = wave >> 2; S.next(i, u); i += 2)       { const int row = tid & 255; const int ai = row >> 7, wr = (row >> 6) & 1, m = (row >> 4) & 3, fr = row & 15;
                const int pp = UPM * u.pm - 1 + 126 * wr + 8 * fr + 4 * ai + m;
                const int tok = min(max(pp - (pp > SEQ ? 1 : 0) - (pp > 2 * SEQ + 1 ? 1 : 0), 0), M - 1);
                const float* p = SSX + (size_t)tok * 16;
                const f32x4 a = *(const f32x4*)p, b = *(const f32x4*)(p + 4), c = *(const f32x4*)(p + 8), d = *(const f32x4*)(p + 12);
                const float s = ((a[0] + a[1]) + (a[2] + a[3])) + ((b[0] + b[1]) + (b[2] + b[3])) + ((c[0] + c[1]) + (c[2] + c[3])) + ((d[0] + d[1]) + (d[2] + d[3]));
                tab[i * 256 + row] = (pp >= 0 && pp < MP && pp != SEQ && pp != 2 * SEQ + 1) ? 1.0f / sqrtf(s * (1.0f / D) + EPS) : 0.f; } }
            __syncthreads();
            pg8::Gemm g{(const char*)(XB - D), Wup_t, D, (long)UPM * D * 2, 4L * D * 2, 128L * D * 2, (long)DFF * D * 2, 1, 0L};
            pg8::EpiUp E{HID, (const float*)(ws + WS_CONV) + (size_t)l * 4 * NUP, tab, lds + TAB_OFF + 18 * 1024};
            pg8::gemm_phase<pg8::EpiUp, true, true>(lds, g, S, E, wave);
        }
        SEAM(pb + 3);

        if (IN(pb + 4)) {
            PHASE_IDS;
            pg8::StaticOrder S; S.init(M / 256, D / 256, G, bx, pg8::WGM, 1);
            pg8::Gemm g{(const char*)HID, Wdn_t, DFF, 256L * DFF * 2, 128L * DFF * 2, 256L * DFF * 2, 128L * DFF * 2, 0, 0L};
            if (l == DEPTH - 1 && FUSE_FINAL) {
                pg8::EpiFin E{XB, out, norm_final, (float*)(ws + WS_XSLOT), ctl + CW_CNT, lds + TAB_OFF};
                pg8::gemm_phase<pg8::EpiFin, true, true>(lds, g, S, E, wave);
            } else {
                pg8::EpiRes<false> E{XB, SSX, nullptr};
                pg8::gemm_phase<pg8::EpiRes<false>, true, false>(lds, g, S, E, wave);
            }
        }
        if (!(FUSE_FINAL && l == DEPTH - 1)) SEAM(pb + 4);
    }

    if (!FUSE_FINAL) for (int rep = 0; rep <= ((REP_MASK >> 6) & 1); ++rep) if (IN(N_PHASES - 1)) {
        PHASE_IDS;
        for (int m0 = 4 * gw; m0 < M; m0 += 4 * NGW) {
            u32x4 rw[4][2]; float sv[4];
#pragma unroll
            for (int r = 0; r < 4; ++r) { const int m = m0 + r; const GAS bf16_t* xr = (const GAS bf16_t*)XB + (size_t)(m + m / SEQ) * D;
                sv[r] = ((const GAS float*)SSX)[(size_t)m * 16 + (lane & 15)];
#pragma unroll
                for (int j = 0; j < 2; ++j) rw[r][j] = *(const GAS u32x4*)(xr + 8 * lane + 512 * j); }
            f32x4 g0[2], g1[2];
#pragma unroll
            for (int j = 0; j < 2; ++j) { g0[j] = *(const GAS f32x4*)((const GAS float*)norm_final + 8 * lane + 512 * j); g1[j] = *(const GAS f32x4*)((const GAS float*)norm_final + 8 * lane + 512 * j + 4); }
#pragma unroll
            for (int r = 0; r < 4; ++r) { const int m = m0 + r; float s = sv[r];
                s += __shfl_xor(s, 1); s += __shfl_xor(s, 2); s += __shfl_xor(s, 4); s += __shfl_xor(s, 8);
                const float inv = 1.0f / sqrtf(s * (1.0f / D) + EPS);
                GAS float* orow = (GAS float*)out + (size_t)m * D;
#pragma unroll
                for (int j = 0; j < 2; ++j) { const u32x4 w = rw[r][j];
                    const f32x4 v0 = (f32x4){pg8::bf_lo(w.x), pg8::bf_hi(w.x), pg8::bf_lo(w.y), pg8::bf_hi(w.y)}, v1 = (f32x4){pg8::bf_lo(w.z), pg8::bf_hi(w.z), pg8::bf_lo(w.w), pg8::bf_hi(w.w)};
                    *(GAS f32x4*)(orow + 8 * lane + 512 * j) = v0 * inv * g0[j]; *(GAS f32x4*)(orow + 8 * lane + 512 * j + 4) = v1 * inv * g1[j]; } }
        }
    }
#undef IN
#undef SEAM
}

extern "C" void kernel_launch(void* const* d_in, const int* in_sizes, int n_in, void* d_out, int out_size, void* d_ws, size_t ws_size, hipStream_t stream) {
    static int grid = 0;
    if (grid == 0) {
        if (n_in != 14 || in_sizes[0] != SEQ * D || in_sizes[1] != 2 * SEQ * D || out_size != M * D || ws_size < WS_END) {
            fprintf(stderr, "kernel_launch: unexpected shapes (n_in %d, in0 %d, in1 %d, out %d, ws %zu; need ws >= %zu); nothing launched\n", n_in, n_in > 0 ? in_sizes[0] : -1, n_in > 1 ? in_sizes[1] : -1, out_size, ws_size, (size_t)WS_END);
            grid = -1; return; }
        int dev = 0, cus = 0;
        if (hipGetDevice(&dev) != hipSuccess || hipDeviceGetAttribute(&cus, hipDeviceAttributeMultiprocessorCount, dev) != hipSuccess) { fprintf(stderr, "kernel_launch: device query failed\n"); grid = -1; return; }
        if (hipFuncSetAttribute((const void*)fwd_kernel, hipFuncAttributeMaxDynamicSharedMemorySize, LDS_BYTES) != hipSuccess) { fprintf(stderr, "kernel_launch: hipFuncSetAttribute failed\n"); grid = -1; return; }
        int per_cu = 0;
        if (hipOccupancyMaxActiveBlocksPerMultiprocessor(&per_cu, (const void*)fwd_kernel, NWAVES * 64, LDS_BYTES) != hipSuccess || per_cu < 1)
            fprintf(stderr, "kernel_launch: note: occupancy query reports %d workgroups per CU\n", per_cu);
        (void)hipGetLastError();
        grid = cus;
    }
    if (grid < 0) return;
    if (hipMemsetAsync((char*)d_ws + WS_CTL, 0, CTL_ZERO_BYTES, stream) != hipSuccess) { fprintf(stderr, "kernel_launch: memset failed\n"); return; }
    Args a{};
    for (int i = 0; i < 14; ++i) a.in[i] = (const float*)d_in[i];
    a.out = (float*)d_out; a.ws = (unsigned char*)d_ws;
    if (MK_N_LAUNCHES == 1) {
        a.ph_lo = 0; a.ph_hi = N_PHASES; a.li = 0;
        hipLaunchKernelGGL(fwd_kernel, dim3(grid), dim3(NWAVES * 64), LDS_BYTES, stream, a);
    } else {
        for (int p = 0; p < N_PHASES; ++p) { a.ph_lo = p; a.ph_hi = p + 1; a.li = p; hipLaunchKernelGGL(fwd_kernel, dim3(grid), dim3(NWAVES * 64), LDS_BYTES, stream, a); }
    }
    const hipError_t le = hipPeekAtLastError();
    if (le != hipSuccess) fprintf(stderr, "kernel_launch: launch failed: %s\n", hipGetErrorName(le));
}
```
